# Optimizing an MI355X kernel written in HIP

```python
import math
import jax, jax.numpy as jnp
from jax import lax
import numpy as np

D_MODEL = 2048
BATCH = 16
SEQ = 2048
DEPTH = 2

D_MIX = D_MODEL
EPS = 1e-5
POOL_WIDTH = D_MIX // 4
POOL_WINDOWS = (2, 4, 8, 16)
POOL_GROUPS = len(POOL_WINDOWS)
POOL_GROUP_DIM = POOL_WIDTH // POOL_GROUPS
MLA_HEADS = 8
MLA_NOPE_DIM = 128
MLA_ROPE_DIM = 64
MLA_V_DIM = 128
MLA_WIDTH = MLA_HEADS * MLA_V_DIM
MLA_Q_RANK = 512
MLA_KV_RANK = 256
MLA_QK_DIM = MLA_NOPE_DIM + MLA_ROPE_DIM
ROPE_THETA = 10000.0
Q_BLOCK = 128
SGU_WIDTH = D_MIX - POOL_WIDTH - MLA_WIDTH
SGU_HEADS = 4
SGU_HEAD_DIM = SGU_WIDTH // SGU_HEADS
SGU_CHUNK = 128
ALPHA = (2.0 * DEPTH) ** 0.25
BETA = (8.0 * DEPTH) ** -0.25

COL_A_X = POOL_WIDTH
COL_A_G = POOL_WIDTH
COL_B_CQ = MLA_Q_RANK
COL_B_CKV = MLA_KV_RANK
COL_B_KR = MLA_ROPE_DIM
COL_B_G = MLA_WIDTH
COL_C_UV = 2 * SGU_WIDTH
COL_C_G = SGU_WIDTH
D_IN_COLS = COL_A_X + COL_A_G + COL_B_CQ + COL_B_CKV + COL_B_KR + COL_B_G + COL_C_UV + COL_C_G
SPLIT_IDX = (
    COL_A_X,
    COL_A_X + COL_A_G,
    COL_A_X + COL_A_G + COL_B_CQ,
    COL_A_X + COL_A_G + COL_B_CQ + COL_B_CKV,
    COL_A_X + COL_A_G + COL_B_CQ + COL_B_CKV + COL_B_KR,
    COL_A_X + COL_A_G + COL_B_CQ + COL_B_CKV + COL_B_KR + COL_B_G,
    COL_A_X + COL_A_G + COL_B_CQ + COL_B_CKV + COL_B_KR + COL_B_G + COL_C_UV,
)

kernel_name = "hybrid_pool_mla_sgu_deepnorm"


def _layer_norm(x, g, b):
    xf = x.astype(jnp.float32)
    mu = jnp.mean(xf, axis=-1, keepdims=True)
    var = jnp.mean(jnp.square(xf - mu), axis=-1, keepdims=True)
    return ((xf - mu) * lax.rsqrt(var + EPS) * g.astype(jnp.float32) + b.astype(jnp.float32)).astype(x.dtype)


def _rms_norm(x, g):
    xf = x.astype(jnp.float32)
    ms = jnp.mean(jnp.square(xf), axis=-1, keepdims=True)
    return (xf * lax.rsqrt(ms + EPS) * g.astype(jnp.float32)).astype(x.dtype)


def _rope(x, cos, sin):
    half = MLA_ROPE_DIM // 2
    xf = x.astype(jnp.float32)
    x1, x2 = xf[..., :half], xf[..., half:]
    out = jnp.concatenate([x1 * cos - x2 * sin, x2 * cos + x1 * sin], axis=-1)
    return out.astype(x.dtype)


def _pool_mixer(xa, w_pool, pool_scale):
    B, S, _ = xa.shape
    xg = xa.reshape(B, S, POOL_GROUPS, POOL_GROUP_DIM)
    cs = jnp.cumsum(xg.astype(jnp.float32), axis=1)
    t = jnp.arange(1, S + 1, dtype=jnp.float32)[None, :, None]
    pooled = []
    for gi, w in enumerate(POOL_WINDOWS):
        c = cs[:, :, gi]
        prev = jnp.pad(c, ((0, 0), (w, 0), (0, 0)))[:, :S]
        pooled.append((c - prev) / jnp.minimum(t, float(w)))
    pooled = jnp.stack(pooled, axis=2).astype(xa.dtype) - xg
    y = jnp.einsum('bsgc,gcd->bsgd', pooled, w_pool)
    return y.reshape(B, S, POOL_WIDTH) * pool_scale


def _mla(cq, ckv, kr, cos, sin, q_norm_g, w_uq, kv_norm_g, w_ukv):
    B, S, _ = cq.shape
    q = jnp.einsum('bsr,rd->bsd', _rms_norm(cq, q_norm_g), w_uq).reshape(B, S, MLA_HEADS, MLA_QK_DIM)
    q_nope = q[..., :MLA_NOPE_DIM]
    q_rope = _rope(q[..., MLA_NOPE_DIM:], cos, sin)
    kv = jnp.einsum('bsr,rd->bsd', _rms_norm(ckv, kv_norm_g), w_ukv).reshape(B, S, MLA_HEADS, MLA_NOPE_DIM + MLA_V_DIM)
    k_nope = kv[..., :MLA_NOPE_DIM]
    v = kv[..., MLA_NOPE_DIM:]
    k_rope = _rope(kr[:, :, None, :], cos, sin)[:, :, 0]
    scale = MLA_QK_DIM ** -0.5
    n_blocks = S // Q_BLOCK
    qn_b = q_nope.reshape(B, n_blocks, Q_BLOCK, MLA_HEADS, MLA_NOPE_DIM).transpose(1, 0, 2, 3, 4)
    qr_b = q_rope.reshape(B, n_blocks, Q_BLOCK, MLA_HEADS, MLA_ROPE_DIM).transpose(1, 0, 2, 3, 4)
    key_idx = jnp.arange(S)

    def one_block(args):
        i, qn, qr = args
        s = (jnp.einsum('bqhd,bkhd->bhqk', qn, k_nope)
             + jnp.einsum('bqhr,bkr->bhqk', qr, k_rope)).astype(jnp.float32) * scale
        q_idx = i * Q_BLOCK + jnp.arange(Q_BLOCK)
        causal = key_idx[None, :] <= q_idx[:, None]
        s = jnp.where(causal[None, None], s, -jnp.inf)
        p = jax.nn.softmax(s, axis=-1).astype(v.dtype)
        return jnp.einsum('bhqk,bkhd->bqhd', p, v)

    out = lax.map(one_block, (jnp.arange(n_blocks), qn_b, qr_b))
    return out.transpose(1, 0, 2, 3, 4).reshape(B, S, MLA_WIDTH)


def _sgu(uv, sgu_norm_g, sgu_norm_b, w_s, b_s):
    B, S, _ = uv.shape
    uv = jax.nn.gelu(uv, approximate=False)
    u, v = uv[..., :SGU_WIDTH], uv[..., SGU_WIDTH:]
    v = _layer_norm(v, sgu_norm_g, sgu_norm_b)
    n_chunks = S // SGU_CHUNK
    v = v.reshape(B, n_chunks, SGU_CHUNK, SGU_HEADS, SGU_HEAD_DIM)
    tril = jnp.tril(jnp.ones((SGU_CHUNK, SGU_CHUNK), dtype=w_s.dtype))
    mixed = jnp.einsum('hts,bcshd->bcthd', w_s * tril, v) + b_s.T[None, None, :, :, None]
    return u * mixed.reshape(B, S, SGU_WIDTH)


def setup_inputs(seed: int = 0) -> dict:
    key = jax.random.key(seed)
    ks = jax.random.split(key, 20)
    f32 = jnp.float32
    nrm = lambda k, shape, s: jax.random.normal(k, shape, f32) * s
    x = jax.random.normal(ks[0], (BATCH, SEQ, D_MODEL), f32)
    offsets = jax.random.randint(ks[1], (BATCH, 1), 0, 1024, dtype=jnp.int32)
    positions = (offsets + jnp.arange(SEQ, dtype=jnp.int32)[None, :]).astype(jnp.int32)
    return {
        "x": x,
        "positions": positions,
        "ln_in_g": 1.0 + nrm(ks[2], (D_MODEL,), 0.02),
        "ln_in_b": nrm(ks[3], (D_MODEL,), 0.02),
        "w_in": nrm(ks[4], (DEPTH, D_MODEL, D_IN_COLS), D_MODEL ** -0.5),
        "pool_w": nrm(ks[5], (DEPTH, POOL_GROUPS, POOL_GROUP_DIM, POOL_GROUP_DIM), POOL_GROUP_DIM ** -0.5),
        "pool_scale": 1.0 + nrm(ks[6], (DEPTH, POOL_WIDTH), 0.1),
        "q_norm_g": 1.0 + nrm(ks[7], (DEPTH, MLA_Q_RANK), 0.02),
        "w_uq": nrm(ks[8], (DEPTH, MLA_Q_RANK, MLA_HEADS * MLA_QK_DIM), MLA_Q_RANK ** -0.5),
        "kv_norm_g": 1.0 + nrm(ks[9], (DEPTH, MLA_KV_RANK), 0.02),
        "w_ukv": nrm(ks[10], (DEPTH, MLA_KV_RANK, MLA_HEADS * (MLA_NOPE_DIM + MLA_V_DIM)), MLA_KV_RANK ** -0.5),
        "sgu_norm_g": 1.0 + nrm(ks[11], (DEPTH, SGU_WIDTH), 0.02),
        "sgu_norm_b": nrm(ks[12], (DEPTH, SGU_WIDTH), 0.02),
        "sgu_w": nrm(ks[13], (DEPTH, SGU_HEADS, SGU_CHUNK, SGU_CHUNK), SGU_CHUNK ** -0.5),
        "sgu_b": 1.0 + nrm(ks[14], (DEPTH, SGU_HEADS, SGU_CHUNK), 0.1),
        "w_out": nrm(ks[15], (DEPTH, D_MIX, D_MODEL), BETA * D_MIX ** -0.5),
        "b_out": nrm(ks[16], (DEPTH, D_MODEL), 0.02),
        "ln_post_g": 1.0 + nrm(ks[17], (DEPTH, D_MODEL), 0.02),
        "ln_post_b": nrm(ks[18], (DEPTH, D_MODEL), 0.02),
    }


def reference(x, positions, ln_in_g, ln_in_b, w_in, pool_w, pool_scale, q_norm_g, w_uq, kv_norm_g, w_ukv,
              sgu_norm_g, sgu_norm_b, sgu_w, sgu_b, w_out, b_out, ln_post_g, ln_post_b):
    half = MLA_ROPE_DIM // 2
    inv_freq = ROPE_THETA ** (-jnp.arange(half, dtype=jnp.float32) / half)
    ang = positions.astype(jnp.float32)[..., None] * inv_freq
    cos = jnp.cos(ang)[:, :, None, :]
    sin = jnp.sin(ang)[:, :, None, :]

    h = _layer_norm(x, ln_in_g, ln_in_b)
    for l in range(DEPTH):
        proj = jnp.einsum('bsd,de->bse', h, w_in[l])
        a_x, a_g, b_cq, b_ckv, b_kr, b_g, c_uv, c_g = jnp.split(proj, SPLIT_IDX, axis=-1)
        y_a = _pool_mixer(a_x, pool_w[l], pool_scale[l]) * jax.nn.silu(a_g)
        y_b = _mla(b_cq, b_ckv, b_kr, cos, sin, q_norm_g[l], w_uq[l], kv_norm_g[l], w_ukv[l]) * jax.nn.silu(b_g)
        y_c = _sgu(c_uv, sgu_norm_g[l], sgu_norm_b[l], sgu_w[l], sgu_b[l]) * jax.nn.silu(c_g)
        y = jnp.concatenate([y_a, y_b, y_c], axis=-1)
        y = jnp.einsum('bse,ed->bsd', y, w_out[l]) + b_out[l]
        h = _layer_norm(ALPHA * h + y, ln_post_g[l], ln_post_b[l])
    return h
```

```cpp
#include <hip/hip_runtime.h>
#include <hip/hip_cooperative_groups.h>
#include <cstdio>
#include <cstdint>
#include <cmath>
namespace cg = cooperative_groups;

#ifndef MK_MULTI
#define MK_MULTI 0
#endif

#ifndef PH_MASK
#define PH_MASK 0xFFFF
#endif
#define PHM(b) constexpr ((PH_MASK >> (b)) & 1)
#ifndef DBL_MASK
#define DBL_MASK 0
#endif
#define REP(b) for (int rep_ = 0; rep_ < 1 + ((DBL_MASK >> (b)) & 1); ++rep_)
#define LAS __attribute__((address_space(3)))
typedef unsigned short bf16_t;
typedef short bf16x8 __attribute__((ext_vector_type(8)));
typedef short s16x4 __attribute__((ext_vector_type(4)));
typedef float f32x4 __attribute__((ext_vector_type(4)));
typedef float f32x2 __attribute__((ext_vector_type(2)));
typedef float f32x16 __attribute__((ext_vector_type(16)));
typedef unsigned u32x4 __attribute__((ext_vector_type(4)));
typedef unsigned u32x2 __attribute__((ext_vector_type(2)));

constexpr int BATCH = 16, SEQ = 2048, DM = 2048, DEPTH = 2;
constexpr int M = BATCH * SEQ;
constexpr int NIN_SRC = 4416, NIN = 4608;
constexpr int PJ_Z = 0, PJ_AG = 512, PJ_CQ = 1024, PJ_CKV = 1536, PJ_BG = 2048, PJ_U = 3072, PJ_V = 3584, PJ_CG = 4096;
constexpr int NQ = 1536, NKN = 1024, NVT = 1024;
constexpr float EPS = 1e-5f;
constexpr float ALPHA = 1.41421356237309515f;
constexpr float QSCALE = 0.07216878364870322f * 1.4426950408889634f;

constexpr size_t MiB = 1u << 20;
constexpr size_t WS_WIN = 1 * MiB;
constexpr size_t WS_WQ = 37 * MiB;
constexpr size_t WS_WKV = 40 * MiB;
constexpr size_t WS_WO = 42 * MiB;
constexpr size_t WS_SGW = 58 * MiB;
constexpr size_t WS_COS = 60 * MiB;
constexpr size_t WS_SIN = 64 * MiB;
constexpr size_t WS_SSQ = 68 * MiB;
constexpr size_t WS_SGST = 70 * MiB;
constexpr size_t WS_KR = 72 * MiB;
constexpr size_t WS_HF = 76 * MiB;
constexpr size_t WS_HB = 332 * MiB;
constexpr size_t WS_PROJ = 460 * MiB;
constexpr size_t WS_Q = 748 * MiB;
constexpr size_t WS_KN = 844 * MiB;
constexpr size_t WS_VT = 908 * MiB;
constexpr size_t WS_END = 972 * MiB;

__device__ __forceinline__ unsigned cvt_pk_bf16(float lo, float hi) { unsigned r; asm volatile("v_cvt_pk_bf16_f32 %0, %1, %2" : "=v"(r) : "v"(lo), "v"(hi)); return r; }
__device__ __forceinline__ float bf_lo(unsigned w) { return __uint_as_float(w << 16); }
__device__ __forceinline__ float bf_hi(unsigned w) { return __uint_as_float(w & 0xffff0000u); }
__device__ __forceinline__ float silu_f(float x) { return x * __builtin_amdgcn_rcpf(1.f + __builtin_amdgcn_exp2f(-1.4426950408889634f * x)); }
__device__ __forceinline__ f32x2 gelu_pk(f32x2 v) {
    const f32x2 av = __builtin_elementwise_abs(v), d = av * 0.2316418882f + 1.0f;
    f32x2 t; t.x = __builtin_amdgcn_rcpf(d.x); t.y = __builtin_amdgcn_rcpf(d.y);
    f32x2 q = t * 0.5307027145f + (-0.7265760135f); q = q * t + 0.7107068705f; q = q * t + (-0.142248368f); q = q * t + 0.127414796f; q = q * t;
    const f32x2 s = (v * v) * (-0.72134752044f);
    f32x2 e; e.x = __builtin_amdgcn_exp2f(s.x); e.y = __builtin_amdgcn_exp2f(s.y);
    const f32x2 m = v * (q * e), r = v - m;
    f32x2 o; o.x = v.x < 0.f ? m.x : r.x; o.y = v.y < 0.f ? m.y : r.y; return o;
}
__device__ __forceinline__ f32x4 gelu4(f32x4 v) { f32x2 a = gelu_pk((f32x2){v[0], v[1]}), b = gelu_pk((f32x2){v[2], v[3]}); return (f32x4){a.x, a.y, b.x, b.y}; }
__device__ __forceinline__ f32x4 silu4(f32x4 v) { return (f32x4){silu_f(v[0]), silu_f(v[1]), silu_f(v[2]), silu_f(v[3])}; }
__device__ __forceinline__ u32x4 pack8(f32x4 a, f32x4 b) { u32x4 w; w.x = cvt_pk_bf16(a[0], a[1]); w.y = cvt_pk_bf16(a[2], a[3]); w.z = cvt_pk_bf16(b[0], b[1]); w.w = cvt_pk_bf16(b[2], b[3]); return w; }
__device__ __forceinline__ int lane_id() { return (int)__builtin_amdgcn_mbcnt_hi(~0u, __builtin_amdgcn_mbcnt_lo(~0u, 0u)); }
__device__ __forceinline__ float shfl_xor_f(float v, int mask) {
    int lane = lane_id(); asm volatile("" : "+v"(lane));
    return __int_as_float(__builtin_amdgcn_ds_bpermute((lane ^ mask) << 2, __float_as_int(v)));
}
__device__ __forceinline__ float wave_sum(float v) {
    int lane = lane_id(); asm volatile("" : "+v"(lane));
#pragma unroll
    for (int o = 1; o < 64; o <<= 1) v += __int_as_float(__builtin_amdgcn_ds_bpermute((lane ^ o) << 2, __float_as_int(v)));
    return v;
}
__host__ __device__ __forceinline__ int rope_perm(int i) { return i < 32 ? 8 * (i >> 2) + (i & 3) : 8 * ((i - 32) >> 2) + 4 + ((i - 32) & 3); }

#define MK_TID(wv) int tid_ = (wv) * 64 + lane_id(); asm volatile("" : "+v"(tid_)); const int tid = tid_
namespace pg8 {
constexpr int BM = 256, BK = 64, HALF = 128, HTB = HALF * BK * 2, STAGE_BYTES = 8 * HTB, NXCD = 8, WGM = 8;
__host__ __device__ __forceinline__ int lds_byte(int r, int c) { const int st = (r >> 4) * 2 + (c >> 5), rr = r & 15, cc = c & 31, ob = rr * 64 + cc * 2; return st * 1024 + (ob ^ (((ob >> 9) & 1) << 5)); }
__host__ __device__ __forceinline__ void stage_rc(int b, int& R, int& C) { const int st = b / 1024, sb = b % 1024, swz = sb ^ (((sb >> 9) & 1) << 5); R = (st >> 1) * 16 + swz / 64; C = (st & 1) * 32 + (swz % 64) / 2; }
__host__ __device__ __forceinline__ int perm32(int rho) { const int n = rho >> 4, i = rho & 15; return 8 * (i >> 2) + 4 * n + (i & 3); }

struct Unit { int pm, pn; };
struct Gemm { const bf16_t* A; const bf16_t* Bt; };

struct StaticOrder {
    int nM, nN, nwg, G, c;
    __host__ __device__ void init(int M_, int N_, int G_, int c_) { nM = M_ / BM; nN = N_ / BM; nwg = nM * nN; G = G_; c = c_; }
    __host__ __device__ bool next(int i, Unit& u) const {
        const long L = (long)i * G + c; if (L >= nwg) return false;
        int wgid = (int)L; { const int q = nwg / NXCD, r = nwg % NXCD, xcd = wgid % NXCD, off = wgid / NXCD; wgid = (xcd < r ? xcd * (q + 1) : r * (q + 1) + (xcd - r) * q) + off; }
        const int nig = WGM * nN, gid = wgid / nig, fm = gid * WGM, gsz = (nM - fm) < WGM ? (nM - fm) : WGM;
        u.pm = fm + ((wgid % nig) % gsz); u.pn = (wgid % nig) / gsz; return true;
    }
};

template <int K, int LDA, int LDB, class Epi, class Sched>
__device__ __forceinline__ void gemm_phase(LAS unsigned char* lds, const Gemm g, const Sched& S, const Epi& E, int wv) {
    MK_TID(wv);
    size_t zo_ = 0; asm volatile("" : "+s"(zo_));
    const char* gA = (const char*)g.A + zo_; const char* gB = (const char*)g.Bt + zo_;
    const int wid = wv, lane = tid & 63, wr = wid >> 2, wc = wid & 3, fr = lane & 15, fq = lane >> 4;
    constexpr int nt = K / BK;
    unsigned voffA[2], voffB[2];
#pragma unroll
    for (int i = 0; i < 2; ++i) { int R, C; stage_rc(tid * 16 + i * 8192, R, C); const int Rb = Epi::PERM ? ((R & ~31) + perm32(R & 31)) : R;
        voffA[i] = (unsigned)(R * LDA + C) * 2u; voffB[i] = (unsigned)(Rb * LDB + C) * 2u; }
    constexpr size_t kstep = (size_t)(BK * 2);
    constexpr size_t hstepA = (size_t)HALF * LDA * 2, hstepB = (size_t)HALF * LDB * 2;
    constexpr size_t tstepA = 2 * hstepA, tstepB = 2 * hstepB;
    const unsigned ldsw = (unsigned)wid * 1024u;
    const int aoff = lds_byte(wr * 64 + fr, fq * 8), boff = lds_byte(wc * 32 + fr, fq * 8);
#define PG8_SA(b, h) (((b) * 2 + (h)) * HTB)
#define PG8_SB(b, h) ((4 + (b) * 2 + (h)) * HTB)
#define PG8_STAGE(bufoff, gbase, voff) do { _Pragma("unroll") for (int _i = 0; _i < 2; ++_i) \
        __builtin_amdgcn_global_load_lds((const unsigned*)((const char*)(gbase) + (voff)[_i]), (LAS unsigned*)(lds + (bufoff) + ldsw + _i * 8192), 16, 0, 0); } while (0)
#define PG8_LDA(dst, b, h) do { _Pragma("unroll") for (int m = 0; m < 4; ++m) _Pragma("unroll") for (int k = 0; k < 2; ++k) dst[m][k] = *(const LAS bf16x8*)(lds + PG8_SA(b, h) + aoff + m * 2048 + k * 1024); } while (0)
#define PG8_LDB(dst, b, h) do { _Pragma("unroll") for (int n = 0; n < 2; ++n) _Pragma("unroll") for (int k = 0; k < 2; ++k) dst[n][k] = *(const LAS bf16x8*)(lds + PG8_SB(b, h) + boff + n * 2048 + k * 1024); } while (0)
#define PG8_MMA(ai, bj, At, Bt) do { __builtin_amdgcn_s_setprio(1); _Pragma("unroll") for (int m = 0; m < 4; ++m) _Pragma("unroll") for (int n = 0; n < 2; ++n) _Pragma("unroll") for (int k = 0; k < 2; ++k) \
        acc[ai][bj][m][n] = __builtin_amdgcn_mfma_f32_16x16x32_bf16(Bt[n][k], At[m][k], acc[ai][bj][m][n], 0, 0, 0); __builtin_amdgcn_s_setprio(0); } while (0)
#define PG8_WAIT_V(n) asm volatile("s_waitcnt vmcnt(" #n ")" ::: "memory")
#define PG8_WAIT_L(n) asm volatile("s_waitcnt lgkmcnt(" #n ")" ::: "memory")
#define PG8_BAR __builtin_amdgcn_s_barrier()
#define PG8_SCHED __builtin_amdgcn_sched_barrier(0)
    Unit cur, nxt; int ui = 0;
    if (!S.next(0, cur)) return;
    f32x4 acc[2][2][4][2];
#pragma unroll
    for (int a = 0; a < 2; ++a)
#pragma unroll
        for (int b = 0; b < 2; ++b)
#pragma unroll
            for (int m = 0; m < 4; ++m)
#pragma unroll
                for (int n = 0; n < 2; ++n) acc[a][b][m][n] = (f32x4){0.f, 0.f, 0.f, 0.f};
    bf16x8 At[4][2], B0[2][2], B1[2][2];
    const char* cA = gA + (size_t)cur.pm * tstepA; const char* cB = gB + (size_t)cur.pn * tstepB;
    PG8_STAGE(PG8_SB(0, 0), cB, voffB); PG8_STAGE(PG8_SB(0, 1), cB + hstepB, voffB); PG8_STAGE(PG8_SA(0, 0), cA, voffA); PG8_STAGE(PG8_SA(0, 1), cA + hstepA, voffA);
    if (wr == 1) PG8_BAR;
    PG8_WAIT_V(2); PG8_BAR;
    PG8_STAGE(PG8_SB(1, 0), cB + kstep, voffB); PG8_STAGE(PG8_SA(1, 0), cA + kstep, voffA); PG8_STAGE(PG8_SB(1, 1), cB + hstepB + kstep, voffB);
    PG8_WAIT_V(6); PG8_BAR;
    for (;;) {
        const bool has_next = S.next(ui + 1, nxt);
        const char* nA = has_next ? gA + (size_t)nxt.pm * tstepA : cA; const char* nB = has_next ? gB + (size_t)nxt.pn * tstepB : cB;
#pragma nounroll
        for (int t = 0; t < nt; t += 2) {
            const bool last = (t == nt - 2);
            const char* a1 = cA + (size_t)(t + 1) * kstep;
            const char* a2 = last ? nA : cA + (size_t)(t + 2) * kstep; const char* b2 = last ? nB : cB + (size_t)(t + 2) * kstep;
            const char* a3 = a2 + kstep; const char* b3 = b2 + kstep;
            PG8_LDB(B0, 0, 0); PG8_LDB(B1, 0, 1); PG8_SCHED; PG8_LDA(At, 0, 0); PG8_STAGE(PG8_SA(1, 1), a1 + hstepA, voffA);
            PG8_WAIT_V(8); PG8_WAIT_L(0); PG8_BAR; PG8_MMA(0, 0, At, B0); PG8_MMA(0, 1, At, B1); PG8_BAR; PG8_SCHED;
            PG8_LDA(At, 0, 1); PG8_STAGE(PG8_SB(0, 0), b2, voffB); PG8_STAGE(PG8_SB(0, 1), b2 + hstepB, voffB); PG8_STAGE(PG8_SA(0, 0), a2, voffA);
            PG8_WAIT_V(8); PG8_WAIT_L(0); PG8_BAR; PG8_MMA(1, 0, At, B0); PG8_MMA(1, 1, At, B1); PG8_BAR; PG8_SCHED;
            PG8_LDB(B0, 1, 0); PG8_LDB(B1, 1, 1); PG8_SCHED; PG8_LDA(At, 1, 0); PG8_STAGE(PG8_SA(0, 1), a2 + hstepA, voffA);
            PG8_WAIT_V(8); PG8_WAIT_L(0); PG8_BAR; PG8_MMA(0, 0, At, B0); PG8_MMA(0, 1, At, B1); PG8_BAR; PG8_SCHED;
            PG8_LDA(At, 1, 1); PG8_STAGE(PG8_SB(1, 0), b3, voffB); PG8_STAGE(PG8_SB(1, 1), b3 + hstepB, voffB); PG8_STAGE(PG8_SA(1, 0), a3, voffA);
            PG8_WAIT_V(8); PG8_WAIT_L(0); PG8_BAR; PG8_MMA(1, 0, At, B0); PG8_MMA(1, 1, At, B1); PG8_BAR; PG8_SCHED;
        }
        if (wr == 0) PG8_BAR;
        E(acc, cur, wr, wc, fr, fq);
        if (!has_next) break;
#pragma unroll
        for (int a = 0; a < 2; ++a)
#pragma unroll
            for (int b = 0; b < 2; ++b)
#pragma unroll
                for (int m = 0; m < 4; ++m)
#pragma unroll
                    for (int n = 0; n < 2; ++n) acc[a][b][m][n] = (f32x4){0.f, 0.f, 0.f, 0.f};
        cur = nxt; cA = nA; cB = nB; ++ui;
        if (wr == 1) PG8_BAR;
    }
    PG8_WAIT_V(0);
    PG8_BAR;
#undef PG8_SA
#undef PG8_SB
#undef PG8_STAGE
#undef PG8_LDA
#undef PG8_LDB
#undef PG8_MMA
#undef PG8_WAIT_V
#undef PG8_WAIT_L
#undef PG8_BAR
#undef PG8_SCHED
}

typedef f32x4 Acc[2][2][4][2];

struct EpiIn {
    static constexpr bool PERM = true;
    bf16_t* proj; bf16_t* krope; float* ssq; float* sgst; const float* cosT; const float* sinT;
    template <int ACT, int ST>
    __device__ __forceinline__ void body(const Acc& acc, const Unit& u, int wr, int wc, int fr, int fq) const {
        const int pn = u.pn, row0 = u.pm * BM + wr * 64 + fr, col0 = pn * BM + wc * 32 + 8 * fq;
#pragma unroll
        for (int ai = 0; ai < 2; ++ai)
#pragma unroll
            for (int m = 0; m < 4; ++m) {
                const int row = row0 + ai * HALF + m * 16; bf16_t* rowp = proj + (size_t)row * NIN + col0; float s1 = 0.f, s2 = 0.f;
#pragma unroll
                for (int bj = 0; bj < 2; ++bj) { f32x4 v0 = acc[ai][bj][m][0], v1 = acc[ai][bj][m][1];
                    if (ACT == 1) { v0 = silu4(v0); v1 = silu4(v1); }
                    if (ACT == 2) { v0 = gelu4(v0); v1 = gelu4(v1); }
                    if (ST >= 1) { s2 += (v0[0] * v0[0] + v0[1] * v0[1]) + (v0[2] * v0[2] + v0[3] * v0[3]) + (v1[0] * v1[0] + v1[1] * v1[1]) + (v1[2] * v1[2] + v1[3] * v1[3]); }
                    if (ST == 2) { s1 += (v0[0] + v0[1]) + (v0[2] + v0[3]) + (v1[0] + v1[1]) + (v1[2] + v1[3]); }
                    *(u32x4*)(rowp + bj * HALF) = pack8(v0, v1); }
                if (ST >= 1) { s2 += shfl_xor_f(s2, 16); s2 += shfl_xor_f(s2, 32); }
                if (ST == 2) { s1 += shfl_xor_f(s1, 16); s1 += shfl_xor_f(s1, 32); }
                if (ST == 1 && fq == 0) ssq[(size_t)row * 12 + (pn - 4) * 4 + wc] = s2;
                if (ST == 2 && fq == 0) *(f32x2*)(sgst + ((size_t)row * 8 + (pn - 14) * 4 + wc) * 2) = (f32x2){s1, s2};
            }
    }
    __device__ __forceinline__ void operator()(const Acc& acc, const Unit& u, int wr, int wc, int fr, int fq) const {
        const int pn = u.pn;
        if (pn == 7) {
            if (wc < 2) { const int row0 = u.pm * BM + wr * 64 + fr, i0 = 16 * wc + 4 * fq;
#pragma unroll
                for (int ai = 0; ai < 2; ++ai) { f32x4 c[4], sn[4];
#pragma unroll
                    for (int m = 0; m < 4; ++m) { const int row = row0 + ai * HALF + m * 16; c[m] = *(const f32x4*)(cosT + (size_t)row * 32 + i0); sn[m] = *(const f32x4*)(sinT + (size_t)row * 32 + i0); }
#pragma unroll
                    for (int m = 0; m < 4; ++m) { const int row = row0 + ai * HALF + m * 16;
                        const f32x4 x1 = acc[ai][0][m][0], x2 = acc[ai][0][m][1];
                        *(u32x4*)(krope + (size_t)row * 64 + 32 * wc + 8 * fq) = pack8(x1 * c[m] - x2 * sn[m], x2 * c[m] + x1 * sn[m]); }
                    asm volatile("" ::: "memory"); } }
            return; }
        if (pn == 2 || pn == 3 || (pn >= 8 && pn <= 11) || pn >= 16) body<1, 0>(acc, u, wr, wc, fr, fq);
        else if (pn == 12 || pn == 13) body<2, 0>(acc, u, wr, wc, fr, fq);
        else if (pn == 14 || pn == 15) body<2, 2>(acc, u, wr, wc, fr, fq);
        else if (pn >= 4 && pn <= 6) body<0, 1>(acc, u, wr, wc, fr, fq);
        else body<0, 0>(acc, u, wr, wc, fr, fq);
    }
};

struct EpiQ {
    static constexpr bool PERM = true;
    bf16_t* Q; const float* ssq; const float* cosT; const float* sinT;
    __device__ __forceinline__ void operator()(const Acc& acc, const Unit& u, int wr, int wc, int fr, int fq) const {
        const int row0 = u.pm * BM + wr * 64 + fr;
        float sc[2][4];
#pragma unroll
        for (int ai = 0; ai < 2; ++ai)
#pragma unroll
            for (int m = 0; m < 4; ++m) { const int row = row0 + ai * HALF + m * 16;
                const f32x4 pa = *(const f32x4*)(ssq + (size_t)row * 12), pb = *(const f32x4*)(ssq + (size_t)row * 12 + 4);
                const float ss = ((pa[0] + pa[1]) + (pa[2] + pa[3])) + ((pb[0] + pb[1]) + (pb[2] + pb[3]));
                sc[ai][m] = __builtin_amdgcn_rsqf(ss * (1.f / 512.f) + EPS) * QSCALE;
                if (m == 1 || m == 3) asm volatile("" : "+v"(sc[ai][m - 1]), "+v"(sc[ai][m]) :: "memory"); }
        const int cb0 = u.pn * BM + wc * 32 + 8 * fq, e00 = cb0 % 192, e01 = (cb0 + HALF) % 192;
        const bool rp0 = e00 >= 128, rp1 = e01 >= 128;
#pragma unroll
        for (int ai = 0; ai < 2; ++ai)
#pragma unroll
            for (int mp = 0; mp < 2; ++mp) { f32x4 c[2][2], sn[2][2];
#pragma unroll
                for (int mm = 0; mm < 2; ++mm) { const int row = row0 + ai * HALF + (2 * mp + mm) * 16;
                    if (rp0) { c[mm][0] = *(const f32x4*)(cosT + (size_t)row * 32 + ((e00 - 128) >> 1)); sn[mm][0] = *(const f32x4*)(sinT + (size_t)row * 32 + ((e00 - 128) >> 1)); }
                    if (rp1) { c[mm][1] = *(const f32x4*)(cosT + (size_t)row * 32 + ((e01 - 128) >> 1)); sn[mm][1] = *(const f32x4*)(sinT + (size_t)row * 32 + ((e01 - 128) >> 1)); } }
#pragma unroll
                for (int mm = 0; mm < 2; ++mm) { const int m = 2 * mp + mm, row = row0 + ai * HALF + m * 16;
#pragma unroll
                    for (int bj = 0; bj < 2; ++bj) { f32x4 v0 = acc[ai][bj][m][0] * sc[ai][m], v1 = acc[ai][bj][m][1] * sc[ai][m];
                        if (bj == 0 ? rp0 : rp1) { const f32x4 o1 = v0 * c[mm][bj] - v1 * sn[mm][bj], o2 = v1 * c[mm][bj] + v0 * sn[mm][bj]; v0 = o1; v1 = o2; }
                        *(u32x4*)(Q + (size_t)row * NQ + cb0 + bj * HALF) = pack8(v0, v1); } }
                asm volatile("" ::: "memory"); }
    }
};
struct EpiKn {
    static constexpr bool PERM = true;
    bf16_t* Kn; const float* ssq;
    __device__ __forceinline__ void operator()(const Acc& acc, const Unit& u, int wr, int wc, int fr, int fq) const {
        const int row0 = u.pm * BM + wr * 64 + fr, col0 = u.pn * BM + wc * 32 + 8 * fq;
        float sc[2][4];
#pragma unroll
        for (int ai = 0; ai < 2; ++ai)
#pragma unroll
            for (int m = 0; m < 4; ++m) { const f32x4 pa = *(const f32x4*)(ssq + (size_t)(row0 + ai * HALF + m * 16) * 12 + 8);
                sc[ai][m] = __builtin_amdgcn_rsqf(((pa[0] + pa[1]) + (pa[2] + pa[3])) * (1.f / 256.f) + EPS); }
#pragma unroll
        for (int ai = 0; ai < 2; ++ai)
#pragma unroll
            for (int m = 0; m < 4; ++m) { const int row = row0 + ai * HALF + m * 16;
#pragma unroll
                for (int bj = 0; bj < 2; ++bj) *(u32x4*)(Kn + (size_t)row * NKN + col0 + bj * HALF) = pack8(acc[ai][bj][m][0] * sc[ai][m], acc[ai][bj][m][1] * sc[ai][m]); }
    }
};
struct EpiVT {
    static constexpr bool PERM = true;
    bf16_t* VT; const float* ssq;
    __device__ __forceinline__ void operator()(const Acc& acc, const Unit& u, int wr, int wc, int fr, int fq) const {
        const int row0 = u.pm * BM + wr * 64 + fr, col0 = u.pn * BM + wc * 32 + 8 * fq;
        f32x4 rs[2][2];
#pragma unroll
        for (int bj = 0; bj < 2; ++bj)
#pragma unroll
            for (int i = 0; i < 8; ++i) { const f32x4 pa = *(const f32x4*)(ssq + (size_t)(col0 + bj * HALF + i) * 12 + 8);
                rs[bj][i >> 2][i & 3] = __builtin_amdgcn_rsqf(((pa[0] + pa[1]) + (pa[2] + pa[3])) * (1.f / 256.f) + EPS); }
#pragma unroll
        for (int ai = 0; ai < 2; ++ai)
#pragma unroll
            for (int m = 0; m < 4; ++m) { const int row = row0 + ai * HALF + m * 16;
#pragma unroll
                for (int bj = 0; bj < 2; ++bj) *(u32x4*)(VT + (size_t)row * M + col0 + bj * HALF) = pack8(acc[ai][bj][m][0] * rs[bj][0], acc[ai][bj][m][1] * rs[bj][1]); }
    }
};
struct EpiOut {
    static constexpr bool PERM = true;
    const float* src; const float* lnst; const float* g; const float* b; float* t; const float* bias;
    __device__ __forceinline__ void operator()(const Acc& acc, const Unit& u, int wr, int wc, int fr, int fq) const {
        const int row0 = u.pm * BM + wr * 64 + fr, col0 = u.pn * BM + wc * 32 + 8 * fq;
        f32x4 ag[2][2], bb[2][2];
#pragma unroll
        for (int bj = 0; bj < 2; ++bj)
#pragma unroll
            for (int n = 0; n < 2; ++n) { const int c = col0 + bj * HALF + 4 * n; ag[bj][n] = *(const f32x4*)(g + c) * ALPHA; bb[bj][n] = *(const f32x4*)(b + c) * ALPHA + *(const f32x4*)(bias + c); }
#pragma unroll
        for (int ai = 0; ai < 2; ++ai)
#pragma unroll
            for (int mp = 0; mp < 2; ++mp) { f32x4 hv[2][2][2]; f32x2 st[2];
#pragma unroll
                for (int mm = 0; mm < 2; ++mm) { const int row = row0 + ai * HALF + (2 * mp + mm) * 16; const size_t off = (size_t)row * DM + col0; st[mm] = *(const f32x2*)(lnst + (size_t)row * 2);
#pragma unroll
                    for (int bj = 0; bj < 2; ++bj)
#pragma unroll
                        for (int n = 0; n < 2; ++n) hv[mm][bj][n] = *(const f32x4*)(src + off + bj * HALF + 4 * n); }
#pragma unroll
                for (int mm = 0; mm < 2; ++mm) { const int m = 2 * mp + mm; const size_t off = (size_t)(row0 + ai * HALF + m * 16) * DM + col0;
#pragma unroll
                    for (int bj = 0; bj < 2; ++bj)
#pragma unroll
                        for (int n = 0; n < 2; ++n) *(f32x4*)(t + off + bj * HALF + 4 * n) = (hv[mm][bj][n] - st[mm].x) * st[mm].y * ag[bj][n] + bb[bj][n] + acc[ai][bj][m][n]; }
                asm volatile("" ::: "memory"); }
    }
};
}

struct Params {
    const float* x; const int* pos; const float* ln_in_g; const float* ln_in_b; const float* w_in; const float* pool_w; const float* pool_scale;
    const float* q_norm_g; const float* w_uq; const float* kv_norm_g; const float* w_ukv; const float* sgu_norm_g; const float* sgu_norm_b;
    const float* sgu_w; const float* sgu_b; const float* w_out; const float* b_out; const float* ln_post_g; const float* ln_post_b;
    float* out; unsigned char* ws; float inv_freq[32]; int ph_lo, ph_hi;
};

constexpr int NWAVES = 8, NTHREADS = 512;
constexpr int RING_BYTES = 131072, LDS_BYTES = 147456;

__device__ __forceinline__ void tr_load(const float* W, int N, int k0, int n0, const float* kscale, LAS float* scr, int lane) {
#pragma unroll
    for (int i = 0; i < 32; ++i) { const int kk = 2 * i + (lane >> 5); float v = W[(size_t)(k0 + kk) * N + n0 + (lane & 31)]; if (kscale) v *= kscale[k0 + kk]; scr[kk * 33 + (lane & 31)] = v; }
}
__device__ __forceinline__ int dest_row(int mat, int n) {
    if (mat == 0) { if (n < 1792) return n; if (n < 1856) return 1792 + rope_perm(n - 1792); return n + 192; }
    if (mat == 1) { const int h = n / 192, e = n % 192; return e < 128 ? n : h * 192 + 128 + rope_perm(e - 128); }
    if (mat == 2) { const int h = n >> 8, e = n & 255; return e < 128 ? h * 128 + e : 1024 + h * 128 + (e - 128); }
    return n;
}
__device__ __forceinline__ void tr_store(LAS float* scr, bf16_t* WT, int K, int k0, int n0, int mat, int lane) {
    asm volatile("s_waitcnt lgkmcnt(0)" ::: "memory");
    const int c = lane & 7;
#pragma unroll
    for (int j = 0; j < 4; ++j) { const int n = (lane >> 3) + 8 * j; const LAS float* s = scr + (8 * c) * 33 + n;
        u32x4 o; o.x = cvt_pk_bf16(s[0 * 33], s[1 * 33]); o.y = cvt_pk_bf16(s[2 * 33], s[3 * 33]); o.z = cvt_pk_bf16(s[4 * 33], s[5 * 33]); o.w = cvt_pk_bf16(s[6 * 33], s[7 * 33]);
        *(u32x4*)(WT + (size_t)dest_row(mat, n0 + n) * K + k0 + 8 * c) = o; }
    asm volatile("s_waitcnt lgkmcnt(0)" ::: "memory");
}

__device__ __forceinline__ void phase_prologue(const Params& p, LAS unsigned char* lds, int vcu, int G, int wv) {
    MK_TID(wv); const int lane = tid & 63, wave = wv;
    LAS float* scr = (LAS float*)(lds + wave * 16384);
    const int gw = vcu * NWAVES + wave, NGW = G * NWAVES;
    unsigned char* ws = p.ws;
    constexpr int I_IN = 32 * 122, I_FOLD = 32 * 16, I_Q = 8 * 48, I_KV = 4 * 64, I_O = 32 * 64, I_LAYER = I_IN + I_FOLD + I_Q + I_KV + I_O;
    for (int it = gw; it < DEPTH * I_LAYER; it += NGW) {
        const int l = it / I_LAYER; int r = it % I_LAYER;
        bf16_t* WinT = (bf16_t*)(ws + WS_WIN) + (size_t)l * NIN * DM;
        if (r < I_IN) { const int kb = r / 122, nb = r % 122 + 16; tr_load(p.w_in + (size_t)l * DM * NIN_SRC, NIN_SRC, kb * 64, nb * 32, nullptr, scr, lane); tr_store(scr, WinT, DM, kb * 64, nb * 32, 0, lane); continue; } r -= I_IN;
        if (r < I_FOLD) {
            const int kb = r / 16, db = r % 16, k0 = kb * 64, d0 = db * 32, g = d0 >> 7;
            const float* wrow = p.w_in + (size_t)l * DM * NIN_SRC + (size_t)(k0 + lane) * NIN_SRC + g * 128;
            const float* pw = p.pool_w + ((size_t)(l * 4 + g) * 128) * 128 + (d0 & 127);
            float a[32];
#pragma unroll
            for (int d = 0; d < 32; ++d) a[d] = 0.f;
            for (int c4 = 0; c4 < 32; ++c4) { const f32x4 w = *(const f32x4*)(wrow + 4 * c4);
#pragma unroll
                for (int j = 0; j < 4; ++j) { const float* pr = pw + (size_t)(4 * c4 + j) * 128;
#pragma unroll
                    for (int d = 0; d < 32; ++d) a[d] += w[j] * pr[d]; } }
            const float* sc = p.pool_scale + l * 512 + d0;
#pragma unroll
            for (int d = 0; d < 32; ++d) WinT[(size_t)(d0 + d) * DM + k0 + lane] = (bf16_t)(cvt_pk_bf16(a[d] * sc[d], 0.f) & 0xffffu);
            continue; } r -= I_FOLD;
        if (r < I_Q) { const int kb = r / 48, nb = r % 48; tr_load(p.w_uq + (size_t)l * 512 * NQ, NQ, kb * 64, nb * 32, p.q_norm_g + l * 512, scr, lane);
            tr_store(scr, (bf16_t*)(ws + WS_WQ) + (size_t)l * NQ * 512, 512, kb * 64, nb * 32, 1, lane); continue; } r -= I_Q;
        if (r < I_KV) { const int kb = r / 64, nb = r % 64; tr_load(p.w_ukv + (size_t)l * 256 * 2048, 2048, kb * 64, nb * 32, p.kv_norm_g + l * 256, scr, lane);
            tr_store(scr, (bf16_t*)(ws + WS_WKV) + (size_t)l * 2048 * 256, 256, kb * 64, nb * 32, 2, lane); continue; } r -= I_KV;
        { const int kb = r / 64, nb = r % 64; tr_load(p.w_out + (size_t)l * DM * DM, DM, kb * 64, nb * 32, nullptr, scr, lane);
            tr_store(scr, (bf16_t*)(ws + WS_WO) + (size_t)l * DM * DM, DM, kb * 64, nb * 32, 3, lane); }
    }
    const int gt = vcu * NTHREADS + tid, NGT = G * NTHREADS;
    for (int i = gt; i < DEPTH * 49152; i += NGT) { const int l = i / 49152, r = i % 49152;
        *(u32x4*)((bf16_t*)(ws + WS_WIN) + (size_t)l * NIN * DM + (size_t)1856 * DM + (size_t)r * 8) = (u32x4){0u, 0u, 0u, 0u}; }
    for (int i = gt; i < DEPTH * 4 * 128 * 128 / 2; i += NGT) { const int e = 2 * i, s = e & 127, t = (e >> 7) & 127; const f32x2 w = *(const f32x2*)(p.sgu_w + e);
        ((unsigned*)(ws + WS_SGW))[i] = cvt_pk_bf16(s <= t ? w.x : 0.f, (s + 1) <= t ? w.y : 0.f); }
    for (int i = gt; i < M * 32; i += NGT) { const int tok = i >> 5, k = i & 31; const float ang = (float)p.pos[tok] * p.inv_freq[k];
        double rev = (double)ang * 0.15915494309189535; rev -= __builtin_rint(rev); const float rf = (float)rev;
        ((float*)(ws + WS_COS))[i] = __builtin_amdgcn_cosf(rf); ((float*)(ws + WS_SIN))[i] = __builtin_amdgcn_sinf(rf); }
}

template <int NR>
__device__ __forceinline__ void wave_sum_n(float (&a)[NR]) {
    int lane = lane_id(); asm volatile("" : "+v"(lane));
#pragma unroll
    for (int o = 1; o < 64; o <<= 1) { const int idx = (lane ^ o) << 2; float t[NR];
#pragma unroll
        for (int i = 0; i < NR; ++i) t[i] = __int_as_float(__builtin_amdgcn_ds_bpermute(idx, __float_as_int(a[i])));
#pragma unroll
        for (int i = 0; i < NR; ++i) a[i] += t[i]; }
}
template <bool FINAL, int NR>
__device__ __forceinline__ void ln_rows(const float* src, const float* g, const float* b, float* of, bf16_t* ob, float* lnst, int m0, int mstride, int lane) {
    f32x4 v[NR][8]; float sa[NR], qa[NR]; size_t row[NR];
#pragma unroll
    for (int i = 0; i < NR; ++i) { const int m = m0 + i * mstride; row[i] = (size_t)(m < M ? m : m0); }
#pragma unroll
    for (int i = 0; i < NR; ++i)
#pragma unroll
        for (int j = 0; j < 8; ++j) v[i][j] = __builtin_nontemporal_load((const f32x4*)(src + row[i] * DM) + lane + 64 * j);
#pragma unroll
    for (int i = 0; i < NR; ++i) { sa[i] = 0.f;
#pragma unroll
        for (int j = 0; j < 8; ++j) sa[i] += (v[i][j][0] + v[i][j][1]) + (v[i][j][2] + v[i][j][3]); }
    wave_sum_n<NR>(sa);
#pragma unroll
    for (int i = 0; i < NR; ++i) { const float mean = sa[i] * (1.f / DM); sa[i] = mean; qa[i] = 0.f;
#pragma unroll
        for (int j = 0; j < 8; ++j) { v[i][j] = v[i][j] - mean; qa[i] += (v[i][j][0] * v[i][j][0] + v[i][j][1] * v[i][j][1]) + (v[i][j][2] * v[i][j][2] + v[i][j][3] * v[i][j][3]); } }
    wave_sum_n<NR>(qa);
#pragma unroll
    for (int i = 0; i < NR; ++i) { qa[i] = 1.f / sqrtf(qa[i] * (1.f / DM) + EPS); if (!FINAL && lane == 0) *(f32x2*)(lnst + row[i] * 2) = (f32x2){sa[i], qa[i]}; }
#pragma unroll
    for (int j = 0; j < 8; ++j) { const f32x4 gg = ((const f32x4*)g)[lane + 64 * j], bb = ((const f32x4*)b)[lane + 64 * j];
#pragma unroll
        for (int i = 0; i < NR; ++i) { const f32x4 o = v[i][j] * qa[i] * gg + bb;
            if (FINAL) __builtin_nontemporal_store(o, (f32x4*)(of + row[i] * DM) + lane + 64 * j);
            else { u32x2 w; w.x = cvt_pk_bf16(o[0], o[1]); w.y = cvt_pk_bf16(o[2], o[3]); ((u32x2*)(ob + row[i] * DM))[lane + 64 * j] = w; } } }
}
template <bool FINAL>
__device__ __forceinline__ void phase_ln(const float* src, const float* g, const float* b, float* of, bf16_t* ob, float* lnst, int vcu, int G, int wv) {
    MK_TID(wv); const int lane = tid & 63, wave = wv; const int NGW = G * NWAVES;
    const int gw = vcu * NWAVES + wave; const bool sp = (M == 16 * NGW);
    for (int q = 0; q * 4 * NGW < M; ++q) { const int m0 = sp ? gw + NGW * (((q & 1) << 3) + (q < 2 ? 1 : 0)) : gw + q * 4 * NGW, st = sp ? 2 * NGW : NGW;
        ln_rows<FINAL, 4>(src, g, b, of, ob, lnst, m0, st, lane); }
}

__device__ __forceinline__ void unpack8(const u32x4 z, float (&f)[8]) { f[0] = bf_lo(z.x); f[1] = bf_hi(z.x); f[2] = bf_lo(z.y); f[3] = bf_hi(z.y); f[4] = bf_lo(z.z); f[5] = bf_hi(z.z); f[6] = bf_lo(z.w); f[7] = bf_hi(z.w); }
__device__ __forceinline__ void phase_pool(const bf16_t* proj, bf16_t* ymix, int vcu, int G, int wv) {
    MK_TID(wv); const int lane = tid & 63, wave = wv;
    const int grp = lane >> 4, w = 2 << grp;
    const float m0 = grp == 0 ? 1.f : 0.f, m1 = grp == 1 ? 1.f : 0.f, m2 = grp == 2 ? 1.f : 0.f, m3 = grp == 3 ? 1.f : 0.f;
    for (int t0 = 4 * (vcu * NWAVES + wave); t0 < M; t0 += 4 * G * NWAVES) {
        const int s0 = t0 & (SEQ - 1);
        const bf16_t* zp = proj + (size_t)t0 * NIN + PJ_Z + 8 * lane;
        u32x4 R[19], gt[4];
#pragma unroll
        for (int r = 0; r < 19; ++r) { R[r] = (u32x4){0u, 0u, 0u, 0u};
            if (r >= 16 || (r >= 16 - w && s0 - 15 + r >= 0)) R[r] = *(const u32x4*)(zp + ((ptrdiff_t)r - 15) * NIN); }
#pragma unroll
        for (int j = 0; j < 4; ++j) gt[j] = *(const u32x4*)(proj + (size_t)(t0 + j) * NIN + PJ_AG + 8 * lane);
        float S[8];
#pragma unroll
        for (int e = 0; e < 8; ++e) S[e] = 0.f;
#pragma unroll
        for (int r = 0; r < 16; ++r) { float f[8]; unpack8(R[r], f);
#pragma unroll
            for (int e = 0; e < 8; ++e) S[e] += f[e]; }
#pragma unroll
        for (int j = 0; j < 4; ++j) {
            if (j > 0) {
                float fa[8], f0[8], f1[8], f2[8], f3[8]; unpack8(R[15 + j], fa); unpack8(R[13 + j], f0); unpack8(R[11 + j], f1); unpack8(R[7 + j], f2); unpack8(R[j - 1], f3);
#pragma unroll
                for (int e = 0; e < 8; ++e) S[e] += fa[e] - (((m0 * f0[e] + m1 * f1[e]) + m2 * f2[e]) + m3 * f3[e]); }
            const int n = (s0 + j + 1) < w ? (s0 + j + 1) : w; const float inv = 1.f / (float)n;
            float c[8], gg[8], o[8]; unpack8(R[15 + j], c); unpack8(gt[j], gg);
#pragma unroll
            for (int e = 0; e < 8; ++e) o[e] = (S[e] * inv - c[e]) * gg[e];
            u32x4 wv_; wv_.x = cvt_pk_bf16(o[0], o[1]); wv_.y = cvt_pk_bf16(o[2], o[3]); wv_.z = cvt_pk_bf16(o[4], o[5]); wv_.w = cvt_pk_bf16(o[6], o[7]);
            *(u32x4*)(ymix + (size_t)(t0 + j) * DM + 8 * lane) = wv_;
        }
    }
}

__device__ __forceinline__ int crow(int r, int hi) { return (r & 3) + 8 * (r >> 2) + 4 * hi; }
constexpr int SG_ROW = 272;
__device__ __forceinline__ void phase_sgu(const Params& p, int l, LAS unsigned char* lds, const bf16_t* proj, const float* sgst, const bf16_t* sgw, bf16_t* ymix, int G, int wv) {
    MK_TID(wv); const int lane = tid & 63, wave = wv, hi = lane >> 5, l32 = lane & 31;
    const float* ng = p.sgu_norm_g + l * 512; const float* nb_ = p.sgu_norm_b + l * 512; const float* bs = p.sgu_b + l * 512;
    for (int it = blockIdx.x; it < 1024; it += G) {
        const int bc = it >> 2, head = it & 3, tok0 = bc * 128;
#pragma unroll
        for (int i = 0; i < 4; ++i) { const int c = tid + 512 * i, s = c >> 4, dc = c & 15; const size_t tok = tok0 + s;
            const f32x4* sp = (const f32x4*)(sgst + tok * 16); const f32x4 q0 = sp[0], q1 = sp[1], q2 = sp[2], q3 = sp[3];
            const float s1 = (q0[0] + q0[2]) + (q1[0] + q1[2]) + (q2[0] + q2[2]) + (q3[0] + q3[2]), s2 = (q0[1] + q0[3]) + (q1[1] + q1[3]) + (q2[1] + q2[3]) + (q3[1] + q3[3]);
            const float mean = s1 * (1.f / 512.f), var = s2 * (1.f / 512.f) - mean * mean, rstd = __builtin_amdgcn_rsqf(fmaxf(var, 0.f) + EPS);
            const u32x4 x = *(const u32x4*)(proj + tok * NIN + PJ_V + head * 128 + dc * 8);
            const float xv[8] = {bf_lo(x.x), bf_hi(x.x), bf_lo(x.y), bf_hi(x.y), bf_lo(x.z), bf_hi(x.z), bf_lo(x.w), bf_hi(x.w)};
            const f32x4 g0 = *(const f32x4*)(ng + head * 128 + dc * 8), g1 = *(const f32x4*)(ng + head * 128 + dc * 8 + 4);
            const f32x4 b0 = *(const f32x4*)(nb_ + head * 128 + dc * 8), b1 = *(const f32x4*)(nb_ + head * 128 + dc * 8 + 4);
#pragma unroll
            for (int j = 0; j < 8; ++j) { const float gj = j < 4 ? g0[j & 3] : g1[j & 3], bj = j < 4 ? b0[j & 3] : b1[j & 3];
                const float v = (xv[j] - mean) * rstd * gj + bj;
                *(LAS bf16_t*)(lds + (dc * 8 + j) * SG_ROW + s * 2) = (bf16_t)(cvt_pk_bf16(v, 0.f) & 0xffffu); } }
        const int tb = wave & 3, dh = wave >> 2;
        const bf16_t* wrow = sgw + ((size_t)((l * 4 + head) * 128) + tb * 32 + l32) * 128 + 8 * hi;
        bf16x8 af[8];
#pragma unroll
        for (int ks = 0; ks < 8; ++ks) { af[ks] = (bf16x8){0, 0, 0, 0, 0, 0, 0, 0}; if (ks < 2 * tb + 2) af[ks] = *(const bf16x8*)(wrow + 16 * ks); }
        __syncthreads();
        f32x16 acc0 = {0, 0, 0, 0, 0, 0, 0, 0, 0, 0, 0, 0, 0, 0, 0, 0}, acc1 = acc0;
        const LAS unsigned char* tb0 = lds + (dh * 64 + l32) * SG_ROW + hi * 16;
#pragma unroll
        for (int ks = 0; ks < 8; ++ks) if (ks < 2 * tb + 2) {
            const bf16x8 b0 = *(const LAS bf16x8*)(tb0 + ks * 32), b1 = *(const LAS bf16x8*)(tb0 + 32 * SG_ROW + ks * 32);
            acc0 = __builtin_amdgcn_mfma_f32_32x32x16_bf16(af[ks], b0, acc0, 0, 0, 0);
            acc1 = __builtin_amdgcn_mfma_f32_32x32x16_bf16(af[ks], b1, acc1, 0, 0, 0);
        }
        LAS float* F = (LAS float*)(lds + 36864);
#pragma unroll
        for (int r = 0; r < 16; ++r) { const int t = tb * 32 + crow(r, hi); F[t * 132 + dh * 64 + l32] = acc0[r]; F[t * 132 + dh * 64 + 32 + l32] = acc1[r]; }
        __syncthreads();
        u32x4 uu[4], cc[4]; float bt[4];
#pragma unroll
        for (int i = 0; i < 4; ++i) { const int c = tid + 512 * i, t = c >> 4, dc = c & 15; const size_t tok = tok0 + t;
            uu[i] = *(const u32x4*)(proj + tok * NIN + PJ_U + head * 128 + dc * 8); cc[i] = *(const u32x4*)(proj + tok * NIN + PJ_CG + head * 128 + dc * 8); bt[i] = bs[head * 128 + t]; }
#pragma unroll
        for (int i = 0; i < 4; ++i) { const int c = tid + 512 * i, t = c >> 4, dc = c & 15; const size_t tok = tok0 + t;
            const f32x4 m0 = *(const LAS f32x4*)(F + t * 132 + dc * 8), m1 = *(const LAS f32x4*)(F + t * 132 + dc * 8 + 4);
            const u32x4 u = uu[i], g = cc[i]; const float b = bt[i];
            u32x4 w; w.x = cvt_pk_bf16(bf_lo(u.x) * (m0[0] + b) * bf_lo(g.x), bf_hi(u.x) * (m0[1] + b) * bf_hi(g.x)); w.y = cvt_pk_bf16(bf_lo(u.y) * (m0[2] + b) * bf_lo(g.y), bf_hi(u.y) * (m0[3] + b) * bf_hi(g.y));
            w.z = cvt_pk_bf16(bf_lo(u.z) * (m1[0] + b) * bf_lo(g.z), bf_hi(u.z) * (m1[1] + b) * bf_hi(g.z)); w.w = cvt_pk_bf16(bf_lo(u.w) * (m1[2] + b) * bf_lo(g.w), bf_hi(u.w) * (m1[3] + b) * bf_hi(g.w));
            *(u32x4*)(ymix + tok * DM + 1536 + head * 128 + dc * 8) = w; }
        __syncthreads();
    }
}

#ifndef ATT_PIPE_QK
#define ATT_PIPE_QK 0
#endif
#ifndef ATT_PIPE_PV
#define ATT_PIPE_PV 0
#endif
namespace att {
__device__ __forceinline__ unsigned cvt_nv(float lo, float hi) { unsigned r; asm("v_cvt_pk_bf16_f32 %0, %1, %2" : "=v"(r) : "v"(lo), "v"(hi)); return r; }
constexpr int KROW = 400, VROW = 136, KBUF = 64 * KROW, VBUF = 128 * VROW, LDS_K = 0, LDS_V = 3 * KBUF;
static_assert(LDS_V + 2 * VBUF <= RING_BYTES, "attention LDS");
__device__ __forceinline__ void unit(LAS unsigned char* lds, int b, int h, int qb, const bf16_t* Q, const bf16_t* Kn, const bf16_t* Kr, const bf16_t* VT, const bf16_t* proj, bf16_t* ymix, int wv) {
    MK_TID(wv); const int lane = tid & 63, wave = wv, hi = lane >> 5, l32 = lane & 31;
#ifdef ATT_FORCE
    const bool shift = ATT_FORCE;
#else
    const bool shift = wave >= 4;
#endif
    const int tok0 = b * SEQ, q0 = qb * 256, NT = 4 * (qb + 1);
    bf16x8 qf[12];
    { const bf16_t* qp = Q + (size_t)(tok0 + q0 + 32 * wave + l32) * NQ + h * 192 + 8 * hi;
#pragma unroll
      for (int ks = 0; ks < 12; ++ks) qf[ks] = *(const bf16x8*)(qp + 16 * ks); }
    const bf16_t* gk = Kn + (size_t)(tok0 + (tid >> 4)) * NKN + h * 128 + (tid & 15) * 8;
    const bf16_t* gr = Kr + (size_t)(tok0 + (tid >> 3)) * 64 + (tid & 7) * 8;
    const bf16_t* gv = VT + (size_t)(h * 128 + (tid >> 3)) * M + tok0 + (tid & 7) * 8;
    const int lk = LDS_K + (tid >> 4) * KROW + (tid & 15) * 16, lr = LDS_K + (tid >> 3) * KROW + 256 + (tid & 7) * 16, lv = LDS_V + (tid >> 3) * VROW + (tid & 7) * 16;
    u32x4 rk0, rk1, rr, rv0, rv1;
#define ATT_LOADK(t) do { rk0 = *(const u32x4*)(gk + (size_t)(64 * (t)) * NKN); rk1 = *(const u32x4*)(gk + (size_t)(64 * (t) + 32) * NKN); rr = *(const u32x4*)(gr + (size_t)(64 * (t)) * 64); } while (0)
#define ATT_LOADV(t) do { rv0 = *(const u32x4*)(gv + 64 * (t)); rv1 = *(const u32x4*)(gv + (size_t)64 * M + 64 * (t)); } while (0)
#define ATT_STOREK(ko) do { *(LAS u32x4*)(lds + (ko) + lk) = rk0; *(LAS u32x4*)(lds + (ko) + lk + 32 * KROW) = rk1; *(LAS u32x4*)(lds + (ko) + lr) = rr; } while (0)
#define ATT_STOREV(vo) do { *(LAS u32x2*)(lds + (vo) + lv) = (u32x2){rv0.x, rv0.y}; *(LAS u32x2*)(lds + (vo) + lv + 8) = (u32x2){rv0.z, rv0.w}; \
        *(LAS u32x2*)(lds + (vo) + lv + 64 * VROW) = (u32x2){rv1.x, rv1.y}; *(LAS u32x2*)(lds + (vo) + lv + 64 * VROW + 8) = (u32x2){rv1.z, rv1.w}; } while (0)
    f32x16 o[4];
#pragma unroll
    for (int i = 0; i < 4; ++i) o[i] = (f32x16){0, 0, 0, 0, 0, 0, 0, 0, 0, 0, 0, 0, 0, 0, 0, 0};
    float mrun = -INFINITY, lrun = 0.f;
    const int qidx = q0 + 32 * wave + l32;
    f32x16 p0, p1; bf16x8 pf[2][2];
#define SB_ __builtin_amdgcn_sched_barrier(0)
#define ATT_KREAD(dst, ks) do { dst[0] = *(const LAS bf16x8*)(kb + (ks) * 32); dst[1] = *(const LAS bf16x8*)(kb + 32 * KROW + (ks) * 32); } while (0)
#if ATT_PIPE_QK
#define ATT_QK(ko) do { const LAS unsigned char* kb = lds + (ko) + LDS_K + l32 * KROW + hi * 16; bf16x8 fa[2][2][2]; \
        p0 = (f32x16){0, 0, 0, 0, 0, 0, 0, 0, 0, 0, 0, 0, 0, 0, 0, 0}; p1 = p0; \
        ATT_KREAD(fa[0][0], 0); ATT_KREAD(fa[0][1], 1); \
        _Pragma("unroll") for (int bt = 0; bt < 6; ++bt) { \
            if (bt + 1 < 6) { ATT_KREAD(fa[(bt + 1) & 1][0], 2 * bt + 2); ATT_KREAD(fa[(bt + 1) & 1][1], 2 * bt + 3); } \
            SB_; \
            p0 = __builtin_amdgcn_mfma_f32_32x32x16_bf16(fa[bt & 1][0][0], qf[2 * bt], p0, 0, 0, 0); p1 = __builtin_amdgcn_mfma_f32_32x32x16_bf16(fa[bt & 1][0][1], qf[2 * bt], p1, 0, 0, 0); \
            p0 = __builtin_amdgcn_mfma_f32_32x32x16_bf16(fa[bt & 1][1][0], qf[2 * bt + 1], p0, 0, 0, 0); p1 = __builtin_amdgcn_mfma_f32_32x32x16_bf16(fa[bt & 1][1][1], qf[2 * bt + 1], p1, 0, 0, 0); \
            SB_; } } while (0)
#else
#define ATT_QK(ko) do { const LAS unsigned char* kb = lds + (ko) + LDS_K + l32 * KROW + hi * 16; \
        p0 = (f32x16){0, 0, 0, 0, 0, 0, 0, 0, 0, 0, 0, 0, 0, 0, 0, 0}; p1 = p0; \
        _Pragma("unroll") for (int ks = 0; ks < 12; ++ks) { const bf16x8 a0 = *(const LAS bf16x8*)(kb + ks * 32), a1 = *(const LAS bf16x8*)(kb + 32 * KROW + ks * 32); \
            p0 = __builtin_amdgcn_mfma_f32_32x32x16_bf16(a0, qf[ks], p0, 0, 0, 0); p1 = __builtin_amdgcn_mfma_f32_32x32x16_bf16(a1, qf[ks], p1, 0, 0, 0); } } while (0)
#endif
#define ATT_QKN(ko) do { const LAS unsigned char* kb = lds + (ko) + LDS_K + l32 * KROW + hi * 16; \
        _Pragma("unroll") for (int ks = 0; ks < 12; ++ks) { const bf16x8 a0 = *(const LAS bf16x8*)(kb + ks * 32), a1 = *(const LAS bf16x8*)(kb + 32 * KROW + ks * 32); \
            if (ks == 0) { p0 = __builtin_amdgcn_mfma_f32_32x32x16_bf16(a0, qf[0], negm, 0, 0, 0); p1 = __builtin_amdgcn_mfma_f32_32x32x16_bf16(a1, qf[0], negm, 0, 0, 0); } \
            else { p0 = __builtin_amdgcn_mfma_f32_32x32x16_bf16(a0, qf[ks], p0, 0, 0, 0); p1 = __builtin_amdgcn_mfma_f32_32x32x16_bf16(a1, qf[ks], p1, 0, 0, 0); } } } while (0)
#define ATT_SM(t) do { \
        if ((t) >= NT - 4) { const int kv0 = 64 * (t) + 4 * hi; \
            _Pragma("unroll") for (int r = 0; r < 16; ++r) { const int kv = kv0 + (r & 3) + 8 * (r >> 2); if (kv > qidx) p0[r] = -INFINITY; if (kv + 32 > qidx) p1[r] = -INFINITY; } } \
        float mx = fmaxf(p0[0], p1[0]); \
        _Pragma("unroll") for (int r = 1; r < 16; ++r) mx = fmaxf(mx, fmaxf(p0[r], p1[r])); \
        mx = fmaxf(mx, shfl_xor_f(mx, 32)); \
        const float mn = fmaxf(mrun, mx), alpha = __builtin_amdgcn_exp2f(mrun - mn); mrun = mn; \
        float rs = 0.f; \
        _Pragma("unroll") for (int r = 0; r < 16; ++r) { p0[r] = __builtin_amdgcn_exp2f(p0[r] - mn); p1[r] = __builtin_amdgcn_exp2f(p1[r] - mn); rs += p0[r] + p1[r]; } \
        lrun = lrun * alpha + rs; \
        if (__any(alpha < 1.f)) { \
            _Pragma("unroll") for (int i = 0; i < 4; ++i) _Pragma("unroll") for (int r = 0; r < 16; ++r) o[i][r] *= alpha; } \
        _Pragma("unroll") for (int j = 0; j < 2; ++j) { u32x4 w0, w1; \
            w0.x = cvt_pk_bf16(p0[8 * j + 0], p0[8 * j + 1]); w0.y = cvt_pk_bf16(p0[8 * j + 2], p0[8 * j + 3]); w0.z = cvt_pk_bf16(p0[8 * j + 4], p0[8 * j + 5]); w0.w = cvt_pk_bf16(p0[8 * j + 6], p0[8 * j + 7]); \
            w1.x = cvt_pk_bf16(p1[8 * j + 0], p1[8 * j + 1]); w1.y = cvt_pk_bf16(p1[8 * j + 2], p1[8 * j + 3]); w1.z = cvt_pk_bf16(p1[8 * j + 4], p1[8 * j + 5]); w1.w = cvt_pk_bf16(p1[8 * j + 6], p1[8 * j + 7]); \
            pf[0][j] = __builtin_bit_cast(bf16x8, w0); pf[1][j] = __builtin_bit_cast(bf16x8, w1); } } while (0)
#define ATT_VREAD(dst, sidx) do { _Pragma("unroll") for (int blk = 0; blk < 4; ++blk) { const int off = blk * 32 * VROW + (sidx) * 32; \
            dst[blk][0] = *(const LAS s16x4*)(vb + off); dst[blk][1] = *(const LAS s16x4*)(vb + off + 16); } } while (0)
#if ATT_PIPE_PV
#define ATT_VREAD(dst, sidx) do { _Pragma("unroll") for (int blk = 0; blk < 4; ++blk) { const int off = blk * 32 * VROW + (sidx) * 32; \
            dst[blk][0] = *(const LAS s16x4*)(vb + off); dst[blk][1] = *(const LAS s16x4*)(vb + off + 16); } } while (0)
#define ATT_PVMMA(sl, blk) do { const s16x4 lo = fv[(sl) & 1][blk][0], hh = fv[(sl) & 1][blk][1]; \
            const bf16x8 a = (bf16x8){lo[0], lo[1], lo[2], lo[3], hh[0], hh[1], hh[2], hh[3]}; \
            o[blk] = __builtin_amdgcn_mfma_f32_32x32x16_bf16(a, pf[(sl) >> 1][(sl) & 1], o[blk], 0, 0, 0); } while (0)
#define ATT_PV(vo) do { const LAS unsigned char* vb = lds + (vo) + LDS_V + l32 * VROW + hi * 8; s16x4 fv[2][4][2]; \
        ATT_VREAD(fv[0], 0); SB_; \
        _Pragma("unroll") for (int sl = 0; sl < 4; ++sl) { \
            ATT_PVMMA(sl, 0); ATT_PVMMA(sl, 1); SB_; \
            if (sl + 1 < 4) ATT_VREAD(fv[(sl + 1) & 1], sl + 1); \
            SB_; \
            ATT_PVMMA(sl, 2); ATT_PVMMA(sl, 3); SB_; } } while (0)
#else
#define ATT_PV(vo) do { const LAS unsigned char* vb = lds + (vo) + LDS_V + l32 * VROW + hi * 8; \
        _Pragma("unroll") for (int blk = 0; blk < 4; ++blk) _Pragma("unroll") for (int hf = 0; hf < 2; ++hf) _Pragma("unroll") for (int j = 0; j < 2; ++j) { const int off = blk * 32 * VROW + (32 * hf + 16 * j) * 2; \
            const s16x4 lo = *(const LAS s16x4*)(vb + off), hh = *(const LAS s16x4*)(vb + off + 16); \
            const bf16x8 a = (bf16x8){lo[0], lo[1], lo[2], lo[3], hh[0], hh[1], hh[2], hh[3]}; \
            o[blk] = __builtin_amdgcn_mfma_f32_32x32x16_bf16(a, pf[hf][j], o[blk], 0, 0, 0); } } while (0)
#endif
    ATT_LOADK(0); ATT_LOADV(0); ATT_STOREK(0); ATT_STOREV(0);
    ATT_LOADK(1); ATT_STOREK(KBUF);
    __syncthreads();
#pragma unroll
    for (int ks = 0; ks < 12; ++ks) asm volatile("" : "+v"(qf[ks]));
    int k0 = 0, k1 = KBUF, k2 = 2 * KBUF, v0 = 0, v1 = VBUF;
#define ATT_TOP(t) do { if ((t) + 2 < NT) ATT_LOADK((t) + 2); if ((t) + 1 < NT) ATT_LOADV((t) + 1); } while (0)
#define ATT_BOT(t) do { if ((t) + 2 < NT) ATT_STOREK(k2); if ((t) + 1 < NT) ATT_STOREV(v1); __syncthreads(); \
        { const int kk = k0; k0 = k1; k1 = k2; k2 = kk; const int vv = v0; v0 = v1; v1 = vv; } } while (0)
    bf16x8 pf2[2][2]; float alpha_n = 1.f;
#define ATT_SMA(t, MASKED) do { \
        if (MASKED) { const int kv0 = 64 * (t) + 4 * hi; \
            _Pragma("unroll") for (int r = 0; r < 16; ++r) { const int kv = kv0 + (r & 3) + 8 * (r >> 2); if (kv > qidx) p0[r] = -INFINITY; if (kv + 32 > qidx) p1[r] = -INFINITY; } } \
        float mx = fmaxf(p0[0], p1[0]); \
        _Pragma("unroll") for (int r = 1; r < 16; ++r) mx = fmaxf(mx, fmaxf(p0[r], p1[r])); \
        mx = fmaxf(mx, shfl_xor_f(mx, 32)); \
        const float mn = fmaxf(mrun, mx); alpha_n = __builtin_amdgcn_exp2f(mrun - mn); mrun = mn; \
        float rs = 0.f; \
        _Pragma("unroll") for (int r = 0; r < 16; ++r) { p0[r] = __builtin_amdgcn_exp2f(p0[r] - mn); p1[r] = __builtin_amdgcn_exp2f(p1[r] - mn); rs += p0[r] + p1[r]; } \
        lrun = lrun * alpha_n + rs; \
        _Pragma("unroll") for (int j = 0; j < 2; ++j) { u32x4 w0, w1; \
            w0.x = cvt_nv(p0[8 * j + 0], p0[8 * j + 1]); w0.y = cvt_nv(p0[8 * j + 2], p0[8 * j + 3]); w0.z = cvt_nv(p0[8 * j + 4], p0[8 * j + 5]); w0.w = cvt_nv(p0[8 * j + 6], p0[8 * j + 7]); \
            w1.x = cvt_nv(p1[8 * j + 0], p1[8 * j + 1]); w1.y = cvt_nv(p1[8 * j + 2], p1[8 * j + 3]); w1.z = cvt_nv(p1[8 * j + 4], p1[8 * j + 5]); w1.w = cvt_nv(p1[8 * j + 6], p1[8 * j + 7]); \
            pf2[0][j] = __builtin_bit_cast(bf16x8, w0); pf2[1][j] = __builtin_bit_cast(bf16x8, w1); } } while (0)
#define ATT_RESC() do { if (__any(alpha_n < 1.f)) { _Pragma("unroll") for (int i = 0; i < 4; ++i) _Pragma("unroll") for (int r = 0; r < 16; ++r) o[i][r] *= alpha_n; } } while (0)
    ATT_QK(0);
    if (NT <= 4) ATT_SMA(0, true); else ATT_SMA(0, false);
    pf[0][0] = pf2[0][0]; pf[0][1] = pf2[0][1]; pf[1][0] = pf2[1][0]; pf[1][1] = pf2[1][1];
    float mref = mrun; f32x16 negm;
#pragma unroll
    for (int r = 0; r < 16; ++r) negm[r] = -mref;
    int t = 0;
#define ATT_VRD(i) do { const int sl_ = (i) >> 2, blk_ = (i) & 3, off_ = blk_ * 32 * VROW + sl_ * 32; fv[(i) & 3][0] = *(const LAS s16x4*)(vb + off_); fv[(i) & 3][1] = *(const LAS s16x4*)(vb + off_ + 16); } while (0)
#define ATT_FUSED(tt, MASKED) do { const LAS unsigned char* vb = lds + v0 + LDS_V + l32 * VROW + hi * 8; s16x4 fv[4][2]; \
        float mxa = -INFINITY, mxb = -INFINITY; f32x2 rs2 = (f32x2){0.f, 0.f}; u32x4 w0a, w1a, w0b, w1b; \
        ATT_VRD(0); \
        _Pragma("unroll") for (int i = 0; i < 16; ++i) { \
            if (i + 1 < 16) ATT_VRD(i + 1); \
            { const int sl_ = i >> 2, blk_ = i & 3; const s16x4 lo = fv[i & 3][0], hh = fv[i & 3][1]; \
              const bf16x8 a_ = (bf16x8){lo[0], lo[1], lo[2], lo[3], hh[0], hh[1], hh[2], hh[3]}; \
              o[blk_] = __builtin_amdgcn_mfma_f32_32x32x16_bf16(a_, pf[sl_ >> 1][sl_ & 1], o[blk_], 0, 0, 0); } \
            if (i < 4) { \
                _Pragma("unroll") for (int r = 4 * i; r < 4 * i + 4; ++r) { \
                    if (MASKED) { const int kv = 64 * (tt) + 4 * hi + (r & 3) + 8 * (r >> 2); if (kv > qidx) p0[r] = -INFINITY; if (kv + 32 > qidx) p1[r] = -INFINITY; } \
                    mxa = fmaxf(mxa, p0[r]); mxb = fmaxf(mxb, p1[r]); } \
            } else if (i == 4) { \
                float mx = fmaxf(mxa, mxb); mx = fmaxf(mx, shfl_xor_f(mx, 32)); alpha_n = 1.f; \
                if (__any(mx > 8.f)) { const float dl = fmaxf(mx, 0.f); mref += dl; alpha_n = __builtin_amdgcn_exp2f(-dl); \
                    _Pragma("unroll") for (int r = 0; r < 16; ++r) { p0[r] -= dl; p1[r] -= dl; negm[r] = -mref; } } \
            } else if (i < 13) { \
                _Pragma("unroll") for (int r = 2 * (i - 5); r < 2 * (i - 5) + 2; ++r) { p0[r] = __builtin_amdgcn_exp2f(p0[r]); p1[r] = __builtin_amdgcn_exp2f(p1[r]); rs2 += (f32x2){p0[r], p1[r]}; } \
            } else if (i == 13) { lrun = lrun * alpha_n + (rs2.x + rs2.y); \
                w0a.x = cvt_nv(p0[0], p0[1]); w0a.y = cvt_nv(p0[2], p0[3]); w0a.z = cvt_nv(p0[4], p0[5]); w0a.w = cvt_nv(p0[6], p0[7]); pf[0][0] = __builtin_bit_cast(bf16x8, w0a); \
                w0b.x = cvt_nv(p0[8], p0[9]); w0b.y = cvt_nv(p0[10], p0[11]); w0b.z = cvt_nv(p0[12], p0[13]); w0b.w = cvt_nv(p0[14], p0[15]); pf[0][1] = __builtin_bit_cast(bf16x8, w0b); \
            } else if (i == 14) { \
                w1a.x = cvt_nv(p1[0], p1[1]); w1a.y = cvt_nv(p1[2], p1[3]); w1a.z = cvt_nv(p1[4], p1[5]); w1a.w = cvt_nv(p1[6], p1[7]); pf[1][0] = __builtin_bit_cast(bf16x8, w1a); \
            } else { \
                w1b.x = cvt_nv(p1[8], p1[9]); w1b.y = cvt_nv(p1[10], p1[11]); w1b.z = cvt_nv(p1[12], p1[13]); w1b.w = cvt_nv(p1[14], p1[15]); } \
            __builtin_amdgcn_sched_barrier(0); } \
        pf[1][1] = __builtin_bit_cast(bf16x8, w1b); } while (0)
    for (; t + 1 < NT - 4; ++t) { ATT_TOP(t); ATT_QKN(k1); __builtin_amdgcn_sched_barrier(0); ATT_FUSED(t + 1, false); ATT_RESC(); ATT_BOT(t); }
    for (; t + 1 < NT; ++t) { ATT_TOP(t); ATT_QKN(k1); __builtin_amdgcn_sched_barrier(0); ATT_FUSED(t + 1, true); ATT_RESC(); ATT_BOT(t); }
#undef ATT_FUSED
#undef ATT_VRD
    { ATT_PV(v0); ATT_BOT(t); }
#undef ATT_TOP
#undef ATT_BOT
#undef ATT_SMA
#undef ATT_RESC
#undef ATT_LOADK
#undef ATT_LOADV
#undef ATT_STOREK
#undef ATT_STOREV
#undef ATT_QK
#undef ATT_QKN
#undef ATT_KREAD
#undef ATT_VREAD
#undef SB_
#undef ATT_SM
#undef ATT_PV
    lrun += shfl_xor_f(lrun, 32);
    const float inv = 1.f / lrun;
    const size_t tok = (size_t)tok0 + qidx;
    u32x2 gts[4][4];
#pragma unroll
    for (int blk = 0; blk < 4; ++blk)
#pragma unroll
        for (int g = 0; g < 4; ++g) gts[blk][g] = *(const u32x2*)(proj + tok * NIN + PJ_BG + h * 128 + 32 * blk + 8 * g + 4 * hi);
#pragma unroll
    for (int blk = 0; blk < 4; ++blk)
#pragma unroll
        for (int g = 0; g < 4; ++g) { const int dv = 32 * blk + 8 * g + 4 * hi; const u32x2 gt = gts[blk][g];
            u32x2 w; w.x = cvt_pk_bf16(o[blk][4 * g + 0] * inv * bf_lo(gt.x), o[blk][4 * g + 1] * inv * bf_hi(gt.x)); w.y = cvt_pk_bf16(o[blk][4 * g + 2] * inv * bf_lo(gt.y), o[blk][4 * g + 3] * inv * bf_hi(gt.y));
            *(u32x2*)(ymix + tok * DM + 512 + h * 128 + dv) = w; }
}
__device__ __forceinline__ void phase(LAS unsigned char* lds, const bf16_t* Q, const bf16_t* Kn, const bf16_t* Kr, const bf16_t* VT, const bf16_t* proj, bf16_t* ymix, int vcu, int G, int wv) {
    for (int n = vcu; n < 1024; n += G) {
        const int i = n >> 8, c = n & 255, bh = c >> 1, par = c & 1;
        const int qb = par ? (5 - i) : (i < 2 ? 7 - i : 3 - i);
        unit(lds, bh >> 3, bh & 7, qb, Q, Kn, Kr, VT, proj, ymix, wv);
    }
}
}

#define XB_TMO      128
#define XB_XCNT(j)  (256  + 64 * (j))
#define XB_XSUB(j)  (1280 + 64 * (j))
#define XB_XGEN(j)  (2304 + 64 * (j))
#define XB_TOP      3328
#define XB_TOPGEN   3392
#define XCD_BAR_WORDS 3456
#define XB_SPIN_CAP (1u << 18)
constexpr int XB_LDS_OFF = 131072 + 64;
__device__ __forceinline__ unsigned xb_ld(unsigned* p)              { return __hip_atomic_load(p, __ATOMIC_RELAXED, __HIP_MEMORY_SCOPE_AGENT); }
__device__ __forceinline__ unsigned xb_add(unsigned* p, unsigned v) { return __hip_atomic_fetch_add(p, v, __ATOMIC_RELAXED, __HIP_MEMORY_SCOPE_AGENT); }
__device__ __forceinline__ unsigned xb_xcc_id() { return (unsigned)__builtin_amdgcn_s_getreg((3 << 11) | 20) & 0xFu; }
#define XB_SPIN(cond, bar) do { unsigned _sp = 0; while (cond) { __builtin_amdgcn_s_sleep(1); \
    if ((++_sp & 255u) == 0u) { if (xb_ld(&(bar)[XB_TMO])) break; if (_sp > XB_SPIN_CAP) { atomicAdd(&(bar)[XB_TMO], 1u); break; } } } } while (0)
__device__ __forceinline__ void xcd_barrier_complete(unsigned* bar, unsigned x, unsigned& nloc, unsigned& nx) {
    const unsigned G = gridDim.x * gridDim.y * gridDim.z;
    unsigned sum, cnt, mine, sp = 0u;
    for (;;) {
        sum = 0u; cnt = 0u; mine = 0u;
#pragma unroll
        for (unsigned j = 0; j < 16; ++j) { const unsigned c = xb_ld(&bar[XB_XCNT(j)]); sum += c; cnt += (c > 0u) ? 1u : 0u; mine = (j == x) ? c : mine; }
        if (sum == G) break;
        __builtin_amdgcn_s_sleep(1);
        if ((++sp & 255u) == 0u) { if (xb_ld(&bar[XB_TMO])) break; if (sp > XB_SPIN_CAP) { atomicAdd(&bar[XB_TMO], 1u); break; } }
    }
    nloc = mine > 0u ? mine : 1u; nx = cnt > 0u ? cnt : 1u;
}
__device__ __forceinline__ void xcd_barrier(unsigned* bar, LAS unsigned char* lds, int wv) {
    asm volatile("s_waitcnt vmcnt(0)" ::: "memory");
    __syncthreads();
    int lane = lane_id(); asm volatile("" : "+v"(lane));
    if (wv == 0 && lane == 0) {
        volatile LAS unsigned* st = (volatile LAS unsigned*)(lds + XB_LDS_OFF);
        const unsigned x = xb_xcc_id();
        __builtin_amdgcn_s_waitcnt(0);
        unsigned nloc = st[0], nx = st[1];
        if (nloc == 0u) { (void)xb_add(&bar[XB_XCNT(x)], 1u); xcd_barrier_complete(bar, x, nloc, nx); st[0] = nloc; st[1] = nx; }
        const unsigned old = xb_add(&bar[XB_XSUB(x)], 1u);
        const unsigned gen = old / nloc;
        if (old + 1u == (gen + 1u) * nloc) {
            __builtin_amdgcn_fence(__ATOMIC_RELEASE, "agent");
            asm volatile("s_waitcnt vmcnt(0)" ::: "memory");
            const unsigned og = xb_add(&bar[XB_TOP], 1u);
            const unsigned tg = og / nx;
            if (og + 1u == (tg + 1u) * nx) xb_add(&bar[XB_TOPGEN], 1u);
            else XB_SPIN(xb_ld(&bar[XB_TOPGEN]) == tg, bar);
            __builtin_amdgcn_fence(__ATOMIC_ACQUIRE, "agent");
            xb_add(&bar[XB_XGEN(x)], 1u);
            asm volatile("s_waitcnt vmcnt(0)" ::: "memory");
        } else {
            XB_SPIN(xb_ld(&bar[XB_XGEN(x)]) == gen, bar);
            __builtin_amdgcn_fence(__ATOMIC_ACQUIRE, "agent");
            asm volatile("s_waitcnt vmcnt(0)" ::: "memory");
        }
    }
    __syncthreads();
}
#ifndef USE_XB
#define USE_XB 1
#endif
#if MK_MULTI
#define IN(k) (p.ph_lo <= (k) && (k) < p.ph_hi)
#else
#define IN(k) true
#endif
#ifndef SYNC_REP
#define SYNC_REP 1
#endif
#define SEAM(k) do { if (IN(k) && IN((k) + 1)) { for (int sr_ = 0; sr_ < SYNC_REP; ++sr_) { if (!USE_XB || (k) == 0) cg::this_grid().sync(); else xcd_barrier((unsigned*)p.ws, lds, wv); } } } while (0)
template <int l>
__device__ __forceinline__ void layer_body(const Params& p, LAS unsigned char* lds, int G, int bx, int vcu, int wv) {
    unsigned char* ws;
        const int P = 1 + 5 * l;
        { size_t zo_ = 0; asm volatile("" : "+s"(zo_)); ws = p.ws + zo_; }
    float* hf = (float*)(ws + WS_HF); bf16_t* hb = (bf16_t*)(ws + WS_HB); bf16_t* ymix = hb;
    bf16_t* proj = (bf16_t*)(ws + WS_PROJ); bf16_t* Qb = (bf16_t*)(ws + WS_Q); bf16_t* Knb = (bf16_t*)(ws + WS_KN); bf16_t* VTb = (bf16_t*)(ws + WS_VT);
    bf16_t* krope = (bf16_t*)(ws + WS_KR); float* ssq = (float*)(ws + WS_SSQ); float* sgst = (float*)(ws + WS_SGST);
    const float* cosT = (const float*)(ws + WS_COS); const float* sinT = (const float*)(ws + WS_SIN);
        if (IN(P)) REP(1) {
            pg8::Gemm g{hb, (const bf16_t*)(ws + WS_WIN) + (size_t)l * NIN * DM};
            pg8::StaticOrder S; S.init(M, NIN, G, bx);
            pg8::EpiIn E{proj, krope, ssq, sgst, cosT, sinT};
            if PHM(2) pg8::gemm_phase<DM, DM, DM>(lds, g, S, E, wv);
        }
        SEAM(P);
        if (IN(P + 1)) {
            REP(9) if PHM(6) phase_sgu(p, l, lds, proj, sgst, (const bf16_t*)(ws + WS_SGW), ymix, G, wv);
            REP(10) if PHM(7) phase_pool(proj, ymix, vcu, G, wv);
            __syncthreads();
            REP(6) { pg8::Gemm g{proj + PJ_CQ, (const bf16_t*)(ws + WS_WQ) + (size_t)l * NQ * 512};
              pg8::StaticOrder S; S.init(M, NQ, G, bx); pg8::EpiQ E{Qb, ssq, cosT, sinT}; if PHM(3) pg8::gemm_phase<512, NIN, 512>(lds, g, S, E, wv); }
            REP(7) { pg8::Gemm g{proj + PJ_CKV, (const bf16_t*)(ws + WS_WKV) + (size_t)l * 2048 * 256};
              pg8::StaticOrder S; S.init(M, NKN, G, bx); pg8::EpiKn E{Knb, ssq}; if PHM(4) pg8::gemm_phase<256, NIN, 256>(lds, g, S, E, wv); }
            REP(8) { pg8::Gemm g{(const bf16_t*)(ws + WS_WKV) + (size_t)l * 2048 * 256 + (size_t)1024 * 256, proj + PJ_CKV};
              pg8::StaticOrder S; S.init(NVT, M, G, bx); pg8::EpiVT E{VTb, ssq}; if PHM(5) pg8::gemm_phase<256, 256, NIN>(lds, g, S, E, wv); }
        }
        SEAM(P + 1);
        if (IN(P + 2)) REP(3) if PHM(8) att::phase(lds, Qb, Knb, krope, VTb, proj, ymix, vcu, G, wv);
        SEAM(P + 2);
        if (IN(P + 3)) REP(4) {
            pg8::Gemm g{ymix, (const bf16_t*)(ws + WS_WO) + (size_t)l * DM * DM};
            pg8::StaticOrder S; S.init(M, DM, G, bx);
            pg8::EpiOut E{l == 0 ? p.x : (const float*)p.out, hf, l == 0 ? p.ln_in_g : p.ln_post_g + (l - 1) * DM, l == 0 ? p.ln_in_b : p.ln_post_b + (l - 1) * DM, p.out, p.b_out + l * DM};
            if PHM(9) pg8::gemm_phase<DM, DM, DM>(lds, g, S, E, wv);
        }
        SEAM(P + 3);
        if (IN(P + 4)) for (int rep_ = 0; rep_ < 1 + (((DBL_MASK >> 5) & 1) && l == 0); ++rep_) {
            if (l == DEPTH - 1) phase_ln<true>(p.out, p.ln_post_g + l * DM, p.ln_post_b + l * DM, p.out, nullptr, nullptr, vcu, G, wv);
            else phase_ln<false>(p.out, p.ln_post_g + l * DM, p.ln_post_b + l * DM, nullptr, hb, hf, vcu, G, wv);
        }
        if (l < DEPTH - 1) SEAM(P + 4);
    }
__global__ void __launch_bounds__(NTHREADS, 2) fwd_kernel(Params p) {
    extern __shared__ __attribute__((aligned(16))) unsigned char lds_raw[];
    LAS unsigned char* lds = (LAS unsigned char*)lds_raw;
    const int G = gridDim.x, bx = blockIdx.x;
    const int wv = __builtin_amdgcn_readfirstlane((int)threadIdx.x >> 6);
    const int vcu = (G % 8 == 0) ? (bx % 8) * (G / 8) + bx / 8 : bx;
    unsigned char* ws = p.ws;
    if (USE_XB) {
        { MK_TID(wv);
          if (tid < 2) ((LAS unsigned*)(lds + XB_LDS_OFF))[tid] = 0u;
          if (bx == 0) for (int i = tid; i < XCD_BAR_WORDS; i += NTHREADS) ((unsigned*)p.ws)[i] = 0u; }
        __syncthreads();
    }
    if (IN(0)) {
        REP(0) if PHM(0) phase_prologue(p, lds, vcu, G, wv);
        REP(11) if PHM(1) phase_ln<false>(p.x, p.ln_in_g, p.ln_in_b, nullptr, (bf16_t*)(ws + WS_HB), (float*)(ws + WS_HF), vcu, G, wv);
    }
    SEAM(0);
    layer_body<0>(p, lds, G, bx, vcu, wv);
    layer_body<1>(p, lds, G, bx, vcu, wv);
#undef IN
#undef SEAM
}
constexpr int NPHASES = 1 + 5 * DEPTH;

extern "C" void kernel_launch(void* const* d_in, const int* in_sizes, int n_in, void* d_out, int out_size, void* d_ws, size_t ws_size, hipStream_t stream) {
    static int grid = 0;
    if (grid == 0) {
        if (n_in != 19 || out_size != M * DM || ws_size < WS_END) { fprintf(stderr, "kernel_launch: unexpected problem (n_in %d, out %d, ws %zu); nothing launched\n", n_in, out_size, ws_size); grid = -1; return; }
        int dev = 0, cus = 0, per_cu = 0;
        (void)hipGetDevice(&dev); (void)hipDeviceGetAttribute(&cus, hipDeviceAttributeMultiprocessorCount, dev);
        if (hipFuncSetAttribute((const void*)fwd_kernel, hipFuncAttributeMaxDynamicSharedMemorySize, LDS_BYTES) != hipSuccess) { fprintf(stderr, "kernel_launch: hipFuncSetAttribute failed\n"); grid = -1; return; }
        if (hipOccupancyMaxActiveBlocksPerMultiprocessor(&per_cu, (const void*)fwd_kernel, NTHREADS, LDS_BYTES) != hipSuccess || per_cu < 1) { fprintf(stderr, "kernel_launch: occupancy query says %d\n", per_cu); per_cu = 1; }
        (void)hipGetLastError();
        grid = cus * (per_cu > 1 ? 1 : per_cu);
        if (grid <= 0) grid = 256;
    }
    if (grid < 0) return;
    Params p{};
    p.x = (const float*)d_in[0]; p.pos = (const int*)d_in[1]; p.ln_in_g = (const float*)d_in[2]; p.ln_in_b = (const float*)d_in[3]; p.w_in = (const float*)d_in[4];
    p.pool_w = (const float*)d_in[5]; p.pool_scale = (const float*)d_in[6]; p.q_norm_g = (const float*)d_in[7]; p.w_uq = (const float*)d_in[8]; p.kv_norm_g = (const float*)d_in[9];
    p.w_ukv = (const float*)d_in[10]; p.sgu_norm_g = (const float*)d_in[11]; p.sgu_norm_b = (const float*)d_in[12]; p.sgu_w = (const float*)d_in[13]; p.sgu_b = (const float*)d_in[14];
    p.w_out = (const float*)d_in[15]; p.b_out = (const float*)d_in[16]; p.ln_post_g = (const float*)d_in[17]; p.ln_post_b = (const float*)d_in[18];
    p.out = (float*)d_out; p.ws = (unsigned char*)d_ws;
    for (int i = 0; i < 32; ++i) p.inv_freq[i] = (float)pow(10000.0, -(double)i / 32.0);
#if MK_MULTI
    for (int k = 0; k < NPHASES; ++k) { p.ph_lo = k; p.ph_hi = k + 1; hipLaunchKernelGGL(fwd_kernel, dim3(grid), dim3(NTHREADS), LDS_BYTES, stream, p); }
#else
    p.ph_lo = 0; p.ph_hi = NPHASES;
    void* args[] = {&p};
    hipError_t e = hipLaunchCooperativeKernel((const void*)fwd_kernel, dim3(grid), dim3(NTHREADS), args, LDS_BYTES, stream);
    if (e != hipSuccess) fprintf(stderr, "kernel_launch: cooperative launch failed: %s (grid %d)\n", hipGetErrorString(e), grid);
#endif
}
```

```cpp
#include <hip/hip_runtime.h>
#include <hip/hip_cooperative_groups.h>
#include <cstdio>
#include <cstdint>
#include <cmath>
namespace cg = cooperative_groups;

#ifndef MK_MULTI
#define MK_MULTI 0
#endif

#ifndef PH_MASK
#define PH_MASK 0xFFFF
#endif
#define PHM(b) constexpr ((PH_MASK >> (b)) & 1)
#ifndef DBL_MASK
#define DBL_MASK 0
#endif
#define REP(b) for (int rep_ = 0; rep_ < 1 + ((DBL_MASK >> (b)) & 1); ++rep_)
#define LAS __attribute__((address_space(3)))
typedef unsigned short bf16_t;
typedef short bf16x8 __attribute__((ext_vector_type(8)));
typedef short s16x4 __attribute__((ext_vector_type(4)));
typedef float f32x4 __attribute__((ext_vector_type(4)));
typedef float f32x2 __attribute__((ext_vector_type(2)));
typedef float f32x16 __attribute__((ext_vector_type(16)));
typedef unsigned u32x4 __attribute__((ext_vector_type(4)));
typedef unsigned u32x2 __attribute__((ext_vector_type(2)));

constexpr int BATCH = 16, SEQ = 2048, DM = 2048, DEPTH = 2;
constexpr int M = BATCH * SEQ;
constexpr int NIN_SRC = 4416, NIN = 4608;
constexpr int PJ_Z = 0, PJ_AG = 512, PJ_CQ = 1024, PJ_CKV = 1536, PJ_BG = 2048, PJ_U = 3072, PJ_V = 3584, PJ_CG = 4096;
constexpr int NQ = 1536, NKN = 1024, NVT = 1024;
constexpr float EPS = 1e-5f;
constexpr float ALPHA = 1.41421356237309515f;
constexpr float QSCALE = 0.07216878364870322f * 1.4426950408889634f;

constexpr size_t MiB = 1u << 20;
constexpr size_t WS_WIN = 1 * MiB;
constexpr size_t WS_WQ = 37 * MiB;
constexpr size_t WS_WKV = 40 * MiB;
constexpr size_t WS_WO = 42 * MiB;
constexpr size_t WS_SGW = 58 * MiB;
constexpr size_t WS_COS = 60 * MiB;
constexpr size_t WS_SIN = 64 * MiB;
constexpr size_t WS_SSQ = 68 * MiB;
constexpr size_t WS_SGST = 70 * MiB;
constexpr size_t WS_KR = 72 * MiB;
constexpr size_t WS_HF = 76 * MiB;
constexpr size_t WS_HB = 332 * MiB;
constexpr size_t WS_PROJ = 460 * MiB;
constexpr size_t WS_Q = 748 * MiB;
constexpr size_t WS_KN = 844 * MiB;
constexpr size_t WS_VT = 908 * MiB;
constexpr size_t WS_END = 972 * MiB;

__device__ __forceinline__ unsigned cvt_pk_bf16(float lo, float hi) { unsigned r; asm volatile("v_cvt_pk_bf16_f32 %0, %1, %2" : "=v"(r) : "v"(lo), "v"(hi)); return r; }
__device__ __forceinline__ float bf_lo(unsigned w) { return __uint_as_float(w << 16); }
__device__ __forceinline__ float bf_hi(unsigned w) { return __uint_as_float(w & 0xffff0000u); }
__device__ __forceinline__ float silu_f(float x) { return x * __builtin_amdgcn_rcpf(1.f + __builtin_amdgcn_exp2f(-1.4426950408889634f * x)); }
__device__ __forceinline__ f32x2 gelu_pk(f32x2 v) {
    const f32x2 av = __builtin_elementwise_abs(v), d = av * 0.2316418882f + 1.0f;
    f32x2 t; t.x = __builtin_amdgcn_rcpf(d.x); t.y = __builtin_amdgcn_rcpf(d.y);
    f32x2 q = t * 0.5307027145f + (-0.7265760135f); q = q * t + 0.7107068705f; q = q * t + (-0.142248368f); q = q * t + 0.127414796f; q = q * t;
    const f32x2 s = (v * v) * (-0.72134752044f);
    f32x2 e; e.x = __builtin_amdgcn_exp2f(s.x); e.y = __builtin_amdgcn_exp2f(s.y);
    const f32x2 m = v * (q * e), r = v - m;
    f32x2 o; o.x = v.x < 0.f ? m.x : r.x; o.y = v.y < 0.f ? m.y : r.y; return o;
}
__device__ __forceinline__ f32x4 gelu4(f32x4 v) { f32x2 a = gelu_pk((f32x2){v[0], v[1]}), b = gelu_pk((f32x2){v[2], v[3]}); return (f32x4){a.x, a.y, b.x, b.y}; }
__device__ __forceinline__ f32x4 silu4(f32x4 v) { return (f32x4){silu_f(v[0]), silu_f(v[1]), silu_f(v[2]), silu_f(v[3])}; }
__device__ __forceinline__ u32x4 pack8(f32x4 a, f32x4 b) { u32x4 w; w.x = cvt_pk_bf16(a[0], a[1]); w.y = cvt_pk_bf16(a[2], a[3]); w.z = cvt_pk_bf16(b[0], b[1]); w.w = cvt_pk_bf16(b[2], b[3]); return w; }
__device__ __forceinline__ int lane_id() { return (int)__builtin_amdgcn_mbcnt_hi(~0u, __builtin_amdgcn_mbcnt_lo(~0u, 0u)); }
__device__ __forceinline__ float shfl_xor_f(float v, int mask) {
    int lane = lane_id(); asm volatile("" : "+v"(lane));
    return __int_as_float(__builtin_amdgcn_ds_bpermute((lane ^ mask) << 2, __float_as_int(v)));
}
__device__ __forceinline__ float wave_sum(float v) {
    int lane = lane_id(); asm volatile("" : "+v"(lane));
#pragma unroll
    for (int o = 1; o < 64; o <<= 1) v += __int_as_float(__builtin_amdgcn_ds_bpermute((lane ^ o) << 2, __float_as_int(v)));
    return v;
}
__host__ __device__ __forceinline__ int rope_perm(int i) { return i < 32 ? 8 * (i >> 2) + (i & 3) : 8 * ((i - 32) >> 2) + 4 + ((i - 32) & 3); }

#define MK_TID(wv) int tid_ = (wv) * 64 + lane_id(); asm volatile("" : "+v"(tid_)); const int tid = tid_
namespace pg8 {
constexpr int BM = 256, BK = 64, HALF = 128, HTB = HALF * BK * 2, STAGE_BYTES = 8 * HTB, NXCD = 8, WGM = 8;
__host__ __device__ __forceinline__ int lds_byte(int r, int c) { const int st = (r >> 4) * 2 + (c >> 5), rr = r & 15, cc = c & 31, ob = rr * 64 + cc * 2; return st * 1024 + (ob ^ (((ob >> 9) & 1) << 5)); }
__host__ __device__ __forceinline__ void stage_rc(int b, int& R, int& C) { const int st = b / 1024, sb = b % 1024, swz = sb ^ (((sb >> 9) & 1) << 5); R = (st >> 1) * 16 + swz / 64; C = (st & 1) * 32 + (swz % 64) / 2; }
__host__ __device__ __forceinline__ int perm32(int rho) { const int n = rho >> 4, i = rho & 15; return 8 * (i >> 2) + 4 * n + (i & 3); }

struct Unit { int pm, pn; };
struct Gemm { const bf16_t* A; const bf16_t* Bt; };

struct StaticOrder {
    int nM, nN, nwg, G, c;
    __host__ __device__ void init(int M_, int N_, int G_, int c_) { nM = M_ / BM; nN = N_ / BM; nwg = nM * nN; G = G_; c = c_; }
    __host__ __device__ bool next(int i, Unit& u) const {
        const long L = (long)i * G + c; if (L >= nwg) return false;
        int wgid = (int)L; { const int q = nwg / NXCD, r = nwg % NXCD, xcd = wgid % NXCD, off = wgid / NXCD; wgid = (xcd < r ? xcd * (q + 1) : r * (q + 1) + (xcd - r) * q) + off; }
        const int nig = WGM * nN, gid = wgid / nig, fm = gid * WGM, gsz = (nM - fm) < WGM ? (nM - fm) : WGM;
        u.pm = fm + ((wgid % nig) % gsz); u.pn = (wgid % nig) / gsz; return true;
    }
};

template <int K, int LDA, int LDB, class Epi, class Sched>
__device__ __forceinline__ void gemm_phase(LAS unsigned char* lds, const Gemm g, const Sched& S, const Epi& E, int wv) {
    MK_TID(wv);
    size_t zo_ = 0; asm volatile("" : "+s"(zo_));
    const char* gA = (const char*)g.A + zo_; const char* gB = (const char*)g.Bt + zo_;
    const int wid = wv, lane = tid & 63, wr = wid >> 2, wc = wid & 3, fr = lane & 15, fq = lane >> 4;
    constexpr int nt = K / BK;
    unsigned voffA[2], voffB[2];
#pragma unroll
    for (int i = 0; i < 2; ++i) { int R, C; stage_rc(tid * 16 + i * 8192, R, C); const int Rb = Epi::PERM ? ((R & ~31) + perm32(R & 31)) : R;
        voffA[i] = (unsigned)(R * LDA + C) * 2u; voffB[i] = (unsigned)(Rb * LDB + C) * 2u; }
    constexpr size_t kstep = (size_t)(BK * 2);
    constexpr size_t hstepA = (size_t)HALF * LDA * 2, hstepB = (size_t)HALF * LDB * 2;
    constexpr size_t tstepA = 2 * hstepA, tstepB = 2 * hstepB;
    const unsigned ldsw = (unsigned)wid * 1024u;
    const int aoff = lds_byte(wr * 64 + fr, fq * 8), boff = lds_byte(wc * 32 + fr, fq * 8);
#define PG8_SA(b, h) (((b) * 2 + (h)) * HTB)
#define PG8_SB(b, h) ((4 + (b) * 2 + (h)) * HTB)
#define PG8_STAGE(bufoff, gbase, voff) do { _Pragma("unroll") for (int _i = 0; _i < 2; ++_i) \
        __builtin_amdgcn_global_load_lds((const unsigned*)((const char*)(gbase) + (voff)[_i]), (LAS unsigned*)(lds + (bufoff) + ldsw + _i * 8192), 16, 0, 0); } while (0)
#define PG8_LDA(dst, b, h) do { _Pragma("unroll") for (int m = 0; m < 4; ++m) _Pragma("unroll") for (int k = 0; k < 2; ++k) dst[m][k] = *(const LAS bf16x8*)(lds + PG8_SA(b, h) + aoff + m * 2048 + k * 1024); } while (0)
#define PG8_LDB(dst, b, h) do { _Pragma("unroll") for (int n = 0; n < 2; ++n) _Pragma("unroll") for (int k = 0; k < 2; ++k) dst[n][k] = *(const LAS bf16x8*)(lds + PG8_SB(b, h) + boff + n * 2048 + k * 1024); } while (0)
#define PG8_MMA(ai, bj, At, Bt) do { __builtin_amdgcn_s_setprio(1); _Pragma("unroll") for (int m = 0; m < 4; ++m) _Pragma("unroll") for (int n = 0; n < 2; ++n) _Pragma("unroll") for (int k = 0; k < 2; ++k) \
        acc[ai][bj][m][n] = __builtin_amdgcn_mfma_f32_16x16x32_bf16(Bt[n][k], At[m][k], acc[ai][bj][m][n], 0, 0, 0); __builtin_amdgcn_s_setprio(0); } while (0)
#define PG8_WAIT_V(n) asm volatile("s_waitcnt vmcnt(" #n ")" ::: "memory")
#define PG8_WAIT_L(n) asm volatile("s_waitcnt lgkmcnt(" #n ")" ::: "memory")
#define PG8_BAR __builtin_amdgcn_s_barrier()
#define PG8_SCHED __builtin_amdgcn_sched_barrier(0)
    Unit cur, nxt; int ui = 0;
    if (!S.next(0, cur)) return;
    f32x4 acc[2][2][4][2];
#pragma unroll
    for (int a = 0; a < 2; ++a)
#pragma unroll
        for (int b = 0; b < 2; ++b)
#pragma unroll
            for (int m = 0; m < 4; ++m)
#pragma unroll
                for (int n = 0; n < 2; ++n) acc[a][b][m][n] = (f32x4){0.f, 0.f, 0.f, 0.f};
    bf16x8 At[4][2], B0[2][2], B1[2][2];
    const char* cA = gA + (size_t)cur.pm * tstepA; const char* cB = gB + (size_t)cur.pn * tstepB;
    PG8_STAGE(PG8_SB(0, 0), cB, voffB); PG8_STAGE(PG8_SB(0, 1), cB + hstepB, voffB); PG8_STAGE(PG8_SA(0, 0), cA, voffA); PG8_STAGE(PG8_SA(0, 1), cA + hstepA, voffA);
    if (wr == 1) PG8_BAR;
    PG8_WAIT_V(2); PG8_BAR;
    PG8_STAGE(PG8_SB(1, 0), cB + kstep, voffB); PG8_STAGE(PG8_SA(1, 0), cA + kstep, voffA); PG8_STAGE(PG8_SB(1, 1), cB + hstepB + kstep, voffB);
    PG8_WAIT_V(6); PG8_BAR;
    for (;;) {
        const bool has_next = S.next(ui + 1, nxt);
        const char* nA = has_next ? gA + (size_t)nxt.pm * tstepA : cA; const char* nB = has_next ? gB + (size_t)nxt.pn * tstepB : cB;
#pragma nounroll
        for (int t = 0; t < nt; t += 2) {
            const bool last = (t == nt - 2);
            const char* a1 = cA + (size_t)(t + 1) * kstep;
            const char* a2 = last ? nA : cA + (size_t)(t + 2) * kstep; const char* b2 = last ? nB : cB + (size_t)(t + 2) * kstep;
            const char* a3 = a2 + kstep; const char* b3 = b2 + kstep;
            PG8_LDB(B0, 0, 0); PG8_LDB(B1, 0, 1); PG8_SCHED; PG8_LDA(At, 0, 0); PG8_STAGE(PG8_SA(1, 1), a1 + hstepA, voffA);
            PG8_WAIT_V(8); PG8_WAIT_L(0); PG8_BAR; PG8_MMA(0, 0, At, B0); PG8_MMA(0, 1, At, B1); PG8_BAR; PG8_SCHED;
            PG8_LDA(At, 0, 1); PG8_STAGE(PG8_SB(0, 0), b2, voffB); PG8_STAGE(PG8_SB(0, 1), b2 + hstepB, voffB); PG8_STAGE(PG8_SA(0, 0), a2, voffA);
            PG8_WAIT_V(8); PG8_WAIT_L(0); PG8_BAR; PG8_MMA(1, 0, At, B0); PG8_MMA(1, 1, At, B1); PG8_BAR; PG8_SCHED;
            PG8_LDB(B0, 1, 0); PG8_LDB(B1, 1, 1); PG8_SCHED; PG8_LDA(At, 1, 0); PG8_STAGE(PG8_SA(0, 1), a2 + hstepA, voffA);
            PG8_WAIT_V(8); PG8_WAIT_L(0); PG8_BAR; PG8_MMA(0, 0, At, B0); PG8_MMA(0, 1, At, B1); PG8_BAR; PG8_SCHED;
            PG8_LDA(At, 1, 1); PG8_STAGE(PG8_SB(1, 0), b3, voffB); PG8_STAGE(PG8_SB(1, 1), b3 + hstepB, voffB); PG8_STAGE(PG8_SA(1, 0), a3, voffA);
            PG8_WAIT_V(8); PG8_WAIT_L(0); PG8_BAR; PG8_MMA(1, 0, At, B0); PG8_MMA(1, 1, At, B1); PG8_BAR; PG8_SCHED;
        }
        if (wr == 0) PG8_BAR;
        PG8_SCHED; asm volatile("" ::: "memory");
        E(acc, cur, wr, wc, fr, fq);
        asm volatile("" ::: "memory"); PG8_SCHED;
        if (!has_next) break;
#pragma unroll
        for (int a = 0; a < 2; ++a)
#pragma unroll
            for (int b = 0; b < 2; ++b)
#pragma unroll
                for (int m = 0; m < 4; ++m)
#pragma unroll
                    for (int n = 0; n < 2; ++n) acc[a][b][m][n] = (f32x4){0.f, 0.f, 0.f, 0.f};
        cur = nxt; cA = nA; cB = nB; ++ui;
        if (wr == 1) PG8_BAR;
    }
    PG8_WAIT_V(0);
    PG8_BAR;
#undef PG8_SA
#undef PG8_SB
#undef PG8_STAGE
#undef PG8_LDA
#undef PG8_LDB
#undef PG8_MMA
#undef PG8_WAIT_V
#undef PG8_WAIT_L
#undef PG8_BAR
#undef PG8_SCHED
}

typedef f32x4 Acc[2][2][4][2];

struct EpiIn {
    static constexpr bool PERM = true;
    bf16_t* proj; bf16_t* krope; float* ssq; float* sgst; const float* cosT; const float* sinT;
    template <int ACT, int ST>
    __device__ __forceinline__ void body(const Acc& acc, const Unit& u, int wr, int wc, int fr, int fq) const {
        const int pn = u.pn, row0 = u.pm * BM + wr * 64 + fr, col0 = pn * BM + wc * 32 + 8 * fq;
#pragma unroll
        for (int ai = 0; ai < 2; ++ai)
#pragma unroll
            for (int m = 0; m < 4; ++m) {
                const int row = row0 + ai * HALF + m * 16; bf16_t* rowp = proj + (size_t)row * NIN + col0; float s1 = 0.f, s2 = 0.f;
#pragma unroll
                for (int bj = 0; bj < 2; ++bj) { f32x4 v0 = acc[ai][bj][m][0], v1 = acc[ai][bj][m][1];
                    if (ACT == 1) { v0 = silu4(v0); v1 = silu4(v1); }
                    if (ACT == 2) { v0 = gelu4(v0); v1 = gelu4(v1); }
                    if (ST >= 1) { s2 += (v0[0] * v0[0] + v0[1] * v0[1]) + (v0[2] * v0[2] + v0[3] * v0[3]) + (v1[0] * v1[0] + v1[1] * v1[1]) + (v1[2] * v1[2] + v1[3] * v1[3]); }
                    if (ST == 2) { s1 += (v0[0] + v0[1]) + (v0[2] + v0[3]) + (v1[0] + v1[1]) + (v1[2] + v1[3]); }
                    *(u32x4*)(rowp + bj * HALF) = pack8(v0, v1); }
                if (ST >= 1) { s2 += shfl_xor_f(s2, 16); s2 += shfl_xor_f(s2, 32); }
                if (ST == 2) { s1 += shfl_xor_f(s1, 16); s1 += shfl_xor_f(s1, 32); }
                if (ST == 1 && fq == 0) ssq[(size_t)row * 12 + (pn - 4) * 4 + wc] = s2;
                if (ST == 2 && fq == 0) *(f32x2*)(sgst + ((size_t)row * 8 + (pn - 14) * 4 + wc) * 2) = (f32x2){s1, s2};
            }
    }
    __device__ __forceinline__ void operator()(const Acc& acc, const Unit& u, int wr, int wc, int fr, int fq) const {
        const int pn = u.pn;
        if (pn == 7) {
            if (wc < 2) { const int row0 = u.pm * BM + wr * 64 + fr, i0 = 16 * wc + 4 * fq;
#pragma unroll
                for (int ai = 0; ai < 2; ++ai) { f32x4 c[4], sn[4];
#pragma unroll
                    for (int m = 0; m < 4; ++m) { const int row = row0 + ai * HALF + m * 16; c[m] = *(const f32x4*)(cosT + (size_t)row * 32 + i0); sn[m] = *(const f32x4*)(sinT + (size_t)row * 32 + i0); }
#pragma unroll
                    for (int m = 0; m < 4; ++m) { const int row = row0 + ai * HALF + m * 16;
                        const f32x4 x1 = acc[ai][0][m][0], x2 = acc[ai][0][m][1];
                        *(u32x4*)(krope + (size_t)row * 64 + 32 * wc + 8 * fq) = pack8(x1 * c[m] - x2 * sn[m], x2 * c[m] + x1 * sn[m]); }
                    asm volatile("" ::: "memory"); } }
            return; }
        if (pn == 2 || pn == 3 || (pn >= 8 && pn <= 11) || pn >= 16) body<1, 0>(acc, u, wr, wc, fr, fq);
        else if (pn == 12 || pn == 13) body<2, 0>(acc, u, wr, wc, fr, fq);
        else if (pn == 14 || pn == 15) body<2, 2>(acc, u, wr, wc, fr, fq);
        else if (pn >= 4 && pn <= 6) body<0, 1>(acc, u, wr, wc, fr, fq);
        else body<0, 0>(acc, u, wr, wc, fr, fq);
    }
};

struct EpiQ {
    static constexpr bool PERM = true;
    bf16_t* Q; const float* ssq; const float* cosT; const float* sinT;
    __device__ __forceinline__ void operator()(const Acc& acc, const Unit& u, int wr, int wc, int fr, int fq) const {
        const int row0 = u.pm * BM + wr * 64 + fr;
        float sc[2][4];
#pragma unroll
        for (int ai = 0; ai < 2; ++ai)
#pragma unroll
            for (int m = 0; m < 4; ++m) { const int row = row0 + ai * HALF + m * 16;
                const f32x4 pa = *(const f32x4*)(ssq + (size_t)row * 12), pb = *(const f32x4*)(ssq + (size_t)row * 12 + 4);
                const float ss = ((pa[0] + pa[1]) + (pa[2] + pa[3])) + ((pb[0] + pb[1]) + (pb[2] + pb[3]));
                sc[ai][m] = __builtin_amdgcn_rsqf(ss * (1.f / 512.f) + EPS) * QSCALE;
                if (m == 1 || m == 3) asm volatile("" : "+v"(sc[ai][m - 1]), "+v"(sc[ai][m]) :: "memory"); }
        const int cb0 = u.pn * BM + wc * 32 + 8 * fq, e00 = cb0 % 192, e01 = (cb0 + HALF) % 192;
        const bool rp0 = e00 >= 128, rp1 = e01 >= 128;
#pragma unroll
        for (int ai = 0; ai < 2; ++ai)
#pragma unroll
            for (int mp = 0; mp < 2; ++mp) { f32x4 c[2][2], sn[2][2];
#pragma unroll
                for (int mm = 0; mm < 2; ++mm) { const int row = row0 + ai * HALF + (2 * mp + mm) * 16;
                    if (rp0) { c[mm][0] = *(const f32x4*)(cosT + (size_t)row * 32 + ((e00 - 128) >> 1)); sn[mm][0] = *(const f32x4*)(sinT + (size_t)row * 32 + ((e00 - 128) >> 1)); }
                    if (rp1) { c[mm][1] = *(const f32x4*)(cosT + (size_t)row * 32 + ((e01 - 128) >> 1)); sn[mm][1] = *(const f32x4*)(sinT + (size_t)row * 32 + ((e01 - 128) >> 1)); } }
#pragma unroll
                for (int mm = 0; mm < 2; ++mm) { const int m = 2 * mp + mm, row = row0 + ai * HALF + m * 16;
#pragma unroll
                    for (int bj = 0; bj < 2; ++bj) { f32x4 v0 = acc[ai][bj][m][0] * sc[ai][m], v1 = acc[ai][bj][m][1] * sc[ai][m];
                        if (bj == 0 ? rp0 : rp1) { const f32x4 o1 = v0 * c[mm][bj] - v1 * sn[mm][bj], o2 = v1 * c[mm][bj] + v0 * sn[mm][bj]; v0 = o1; v1 = o2; }
                        *(u32x4*)(Q + (size_t)row * NQ + cb0 + bj * HALF) = pack8(v0, v1); } }
                asm volatile("" ::: "memory"); }
    }
};
struct EpiKn {
    static constexpr bool PERM = true;
    bf16_t* Kn; const float* ssq;
    __device__ __forceinline__ void operator()(const Acc& acc, const Unit& u, int wr, int wc, int fr, int fq) const {
        const int row0 = u.pm * BM + wr * 64 + fr, col0 = u.pn * BM + wc * 32 + 8 * fq;
        float sc[2][4];
#pragma unroll
        for (int ai = 0; ai < 2; ++ai)
#pragma unroll
            for (int m = 0; m < 4; ++m) { const f32x4 pa = *(const f32x4*)(ssq + (size_t)(row0 + ai * HALF + m * 16) * 12 + 8);
                sc[ai][m] = __builtin_amdgcn_rsqf(((pa[0] + pa[1]) + (pa[2] + pa[3])) * (1.f / 256.f) + EPS); }
#pragma unroll
        for (int ai = 0; ai < 2; ++ai)
#pragma unroll
            for (int m = 0; m < 4; ++m) { const int row = row0 + ai * HALF + m * 16;
#pragma unroll
                for (int bj = 0; bj < 2; ++bj) *(u32x4*)(Kn + (size_t)row * NKN + col0 + bj * HALF) = pack8(acc[ai][bj][m][0] * sc[ai][m], acc[ai][bj][m][1] * sc[ai][m]); }
    }
};
struct EpiVT {
    static constexpr bool PERM = true;
    bf16_t* VT; const float* ssq;
    __device__ __forceinline__ void operator()(const Acc& acc, const Unit& u, int wr, int wc, int fr, int fq) const {
        const int row0 = u.pm * BM + wr * 64 + fr, col0 = u.pn * BM + wc * 32 + 8 * fq;
        f32x4 rs[2][2];
#pragma unroll
        for (int bj = 0; bj < 2; ++bj)
#pragma unroll
            for (int i = 0; i < 8; ++i) { const f32x4 pa = *(const f32x4*)(ssq + (size_t)(col0 + bj * HALF + i) * 12 + 8);
                rs[bj][i >> 2][i & 3] = __builtin_amdgcn_rsqf(((pa[0] + pa[1]) + (pa[2] + pa[3])) * (1.f / 256.f) + EPS); }
#pragma unroll
        for (int ai = 0; ai < 2; ++ai)
#pragma unroll
            for (int m = 0; m < 4; ++m) { const int row = row0 + ai * HALF + m * 16;
#pragma unroll
                for (int bj = 0; bj < 2; ++bj) *(u32x4*)(VT + (size_t)row * M + col0 + bj * HALF) = pack8(acc[ai][bj][m][0] * rs[bj][0], acc[ai][bj][m][1] * rs[bj][1]); }
    }
};
struct EpiOut {
    static constexpr bool PERM = true;
    const float* src; const float* lnst; const float* g; const float* b; float* t; const float* bias;
    __device__ __forceinline__ void operator()(const Acc& acc, const Unit& u, int wr, int wc, int fr, int fq) const {
        const int row0 = u.pm * BM + wr * 64 + fr, col0 = u.pn * BM + wc * 32 + 8 * fq;
        f32x4 ag[2][2], bb[2][2];
#pragma unroll
        for (int bj = 0; bj < 2; ++bj)
#pragma unroll
            for (int n = 0; n < 2; ++n) { const int c = col0 + bj * HALF + 4 * n; ag[bj][n] = *(const f32x4*)(g + c) * ALPHA; bb[bj][n] = *(const f32x4*)(b + c) * ALPHA + *(const f32x4*)(bias + c); }
#pragma unroll
        for (int ai = 0; ai < 2; ++ai)
#pragma unroll
            for (int mp = 0; mp < 2; ++mp) { f32x4 hv[2][2][2]; f32x2 st[2];
#pragma unroll
                for (int mm = 0; mm < 2; ++mm) { const int row = row0 + ai * HALF + (2 * mp + mm) * 16; const size_t off = (size_t)row * DM + col0; st[mm] = *(const f32x2*)(lnst + (size_t)row * 2);
#pragma unroll
                    for (int bj = 0; bj < 2; ++bj)
#pragma unroll
                        for (int n = 0; n < 2; ++n) hv[mm][bj][n] = *(const f32x4*)(src + off + bj * HALF + 4 * n); }
#pragma unroll
                for (int mm = 0; mm < 2; ++mm) { const int m = 2 * mp + mm; const size_t off = (size_t)(row0 + ai * HALF + m * 16) * DM + col0;
#pragma unroll
                    for (int bj = 0; bj < 2; ++bj)
#pragma unroll
                        for (int n = 0; n < 2; ++n) *(f32x4*)(t + off + bj * HALF + 4 * n) = (hv[mm][bj][n] - st[mm].x) * st[mm].y * ag[bj][n] + bb[bj][n] + acc[ai][bj][m][n]; }
                asm volatile("" ::: "memory"); }
    }
};
}

struct Params {
    const float* x; const int* pos; const float* ln_in_g; const float* ln_in_b; const float* w_in; const float* pool_w; const float* pool_scale;
    const float* q_norm_g; const float* w_uq; const float* kv_norm_g; const float* w_ukv; const float* sgu_norm_g; const float* sgu_norm_b;
    const float* sgu_w; const float* sgu_b; const float* w_out; const float* b_out; const float* ln_post_g; const float* ln_post_b;
    float* out; unsigned char* ws; float inv_freq[32]; int ph_lo, ph_hi;
};

constexpr int NWAVES = 8, NTHREADS = 512;
constexpr int RING_BYTES = 131072, LDS_BYTES = 147456;

__device__ __forceinline__ void tr_load(const float* W, int N, int k0, int n0, const float* kscale, LAS float* scr, int lane) {
#pragma unroll
    for (int i = 0; i < 32; ++i) { const int kk = 2 * i + (lane >> 5); float v = W[(size_t)(k0 + kk) * N + n0 + (lane & 31)]; if (kscale) v *= kscale[k0 + kk]; scr[kk * 33 + (lane & 31)] = v; }
}
__device__ __forceinline__ int dest_row(int mat, int n) {
    if (mat == 0) { if (n < 1792) return n; if (n < 1856) return 1792 + rope_perm(n - 1792); return n + 192; }
    if (mat == 1) { const int h = n / 192, e = n % 192; return e < 128 ? n : h * 192 + 128 + rope_perm(e - 128); }
    if (mat == 2) { const int h = n >> 8, e = n & 255; return e < 128 ? h * 128 + e : 1024 + h * 128 + (e - 128); }
    return n;
}
__device__ __forceinline__ void tr_store(LAS float* scr, bf16_t* WT, int K, int k0, int n0, int mat, int lane) {
    asm volatile("s_waitcnt lgkmcnt(0)" ::: "memory");
    const int c = lane & 7;
#pragma unroll
    for (int j = 0; j < 4; ++j) { const int n = (lane >> 3) + 8 * j; const LAS float* s = scr + (8 * c) * 33 + n;
        u32x4 o; o.x = cvt_pk_bf16(s[0 * 33], s[1 * 33]); o.y = cvt_pk_bf16(s[2 * 33], s[3 * 33]); o.z = cvt_pk_bf16(s[4 * 33], s[5 * 33]); o.w = cvt_pk_bf16(s[6 * 33], s[7 * 33]);
        *(u32x4*)(WT + (size_t)dest_row(mat, n0 + n) * K + k0 + 8 * c) = o; }
    asm volatile("s_waitcnt lgkmcnt(0)" ::: "memory");
}

__device__ __forceinline__ void phase_prologue(const Params& p, LAS unsigned char* lds, int vcu, int G, int wv) {
    MK_TID(wv); const int lane = tid & 63, wave = wv;
    LAS float* scr = (LAS float*)(lds + wave * 16384);
    const int gw = vcu * NWAVES + wave, NGW = G * NWAVES;
    unsigned char* ws = p.ws;
    constexpr int I_IN = 32 * 122, I_FOLD = 32 * 16, I_Q = 8 * 48, I_KV = 4 * 64, I_O = 32 * 64, I_LAYER = I_IN + I_FOLD + I_Q + I_KV + I_O;
    for (int it = gw; it < DEPTH * I_LAYER; it += NGW) {
        const int l = it / I_LAYER; int r = it % I_LAYER;
        bf16_t* WinT = (bf16_t*)(ws + WS_WIN) + (size_t)l * NIN * DM;
        if (r < I_IN) { const int kb = r / 122, nb = r % 122 + 16; tr_load(p.w_in + (size_t)l * DM * NIN_SRC, NIN_SRC, kb * 64, nb * 32, nullptr, scr, lane); tr_store(scr, WinT, DM, kb * 64, nb * 32, 0, lane); continue; } r -= I_IN;
        if (r < I_FOLD) {
            const int kb = r / 16, db = r % 16, k0 = kb * 64, d0 = db * 32, g = d0 >> 7;
            const float* wrow = p.w_in + (size_t)l * DM * NIN_SRC + (size_t)(k0 + lane) * NIN_SRC + g * 128;
            const float* pw = p.pool_w + ((size_t)(l * 4 + g) * 128) * 128 + (d0 & 127);
            float a[32];
#pragma unroll
            for (int d = 0; d < 32; ++d) a[d] = 0.f;
            for (int c4 = 0; c4 < 32; ++c4) { const f32x4 w = *(const f32x4*)(wrow + 4 * c4);
#pragma unroll
                for (int j = 0; j < 4; ++j) { const float* pr = pw + (size_t)(4 * c4 + j) * 128;
#pragma unroll
                    for (int d = 0; d < 32; ++d) a[d] += w[j] * pr[d]; } }
            const float* sc = p.pool_scale + l * 512 + d0;
#pragma unroll
            for (int d = 0; d < 32; ++d) WinT[(size_t)(d0 + d) * DM + k0 + lane] = (bf16_t)(cvt_pk_bf16(a[d] * sc[d], 0.f) & 0xffffu);
            continue; } r -= I_FOLD;
        if (r < I_Q) { const int kb = r / 48, nb = r % 48; tr_load(p.w_uq + (size_t)l * 512 * NQ, NQ, kb * 64, nb * 32, p.q_norm_g + l * 512, scr, lane);
            tr_store(scr, (bf16_t*)(ws + WS_WQ) + (size_t)l * NQ * 512, 512, kb * 64, nb * 32, 1, lane); continue; } r -= I_Q;
        if (r < I_KV) { const int kb = r / 64, nb = r % 64; tr_load(p.w_ukv + (size_t)l * 256 * 2048, 2048, kb * 64, nb * 32, p.kv_norm_g + l * 256, scr, lane);
            tr_store(scr, (bf16_t*)(ws + WS_WKV) + (size_t)l * 2048 * 256, 256, kb * 64, nb * 32, 2, lane); continue; } r -= I_KV;
        { const int kb = r / 64, nb = r % 64; tr_load(p.w_out + (size_t)l * DM * DM, DM, kb * 64, nb * 32, nullptr, scr, lane);
            tr_store(scr, (bf16_t*)(ws + WS_WO) + (size_t)l * DM * DM, DM, kb * 64, nb * 32, 3, lane); }
    }
    const int gt = vcu * NTHREADS + tid, NGT = G * NTHREADS;
    for (int i = gt; i < DEPTH * 49152; i += NGT) { const int l = i / 49152, r = i % 49152;
        *(u32x4*)((bf16_t*)(ws + WS_WIN) + (size_t)l * NIN * DM + (size_t)1856 * DM + (size_t)r * 8) = (u32x4){0u, 0u, 0u, 0u}; }
    for (int i = gt; i < DEPTH * 4 * 128 * 128 / 2; i += NGT) { const int e = 2 * i, s = e & 127, t = (e >> 7) & 127; const f32x2 w = *(const f32x2*)(p.sgu_w + e);
        ((unsigned*)(ws + WS_SGW))[i] = cvt_pk_bf16(s <= t ? w.x : 0.f, (s + 1) <= t ? w.y : 0.f); }
    for (int i = gt; i < M * 32; i += NGT) { const int tok = i >> 5, k = i & 31; const float ang = (float)p.pos[tok] * p.inv_freq[k];
        double rev = (double)ang * 0.15915494309189535; rev -= __builtin_rint(rev); const float rf = (float)rev;
        ((float*)(ws + WS_COS))[i] = __builtin_amdgcn_cosf(rf); ((float*)(ws + WS_SIN))[i] = __builtin_amdgcn_sinf(rf); }
}

template <int NR>
__device__ __forceinline__ void wave_sum_n(float (&a)[NR]) {
    int lane = lane_id(); asm volatile("" : "+v"(lane));
#pragma unroll
    for (int o = 1; o < 64; o <<= 1) { const int idx = (lane ^ o) << 2; float t[NR];
#pragma unroll
        for (int i = 0; i < NR; ++i) t[i] = __int_as_float(__builtin_amdgcn_ds_bpermute(idx, __float_as_int(a[i])));
#pragma unroll
        for (int i = 0; i < NR; ++i) a[i] += t[i]; }
}
template <bool FINAL, int NR>
__device__ __forceinline__ void ln_rows(const float* src, const float* g, const float* b, float* of, bf16_t* ob, float* lnst, int m0, int mstride, int lane) {
    f32x4 v[NR][8]; float sa[NR], qa[NR]; size_t row[NR];
#pragma unroll
    for (int i = 0; i < NR; ++i) { const int m = m0 + i * mstride; row[i] = (size_t)(m < M ? m : m0); }
#pragma unroll
    for (int i = 0; i < NR; ++i)
#pragma unroll
        for (int j = 0; j < 8; ++j) v[i][j] = __builtin_nontemporal_load((const f32x4*)(src + row[i] * DM) + lane + 64 * j);
#pragma unroll
    for (int i = 0; i < NR; ++i) { sa[i] = 0.f;
#pragma unroll
        for (int j = 0; j < 8; ++j) sa[i] += (v[i][j][0] + v[i][j][1]) + (v[i][j][2] + v[i][j][3]); }
    wave_sum_n<NR>(sa);
#pragma unroll
    for (int i = 0; i < NR; ++i) { const float mean = sa[i] * (1.f / DM); sa[i] = mean; qa[i] = 0.f;
#pragma unroll
        for (int j = 0; j < 8; ++j) { v[i][j] = v[i][j] - mean; qa[i] += (v[i][j][0] * v[i][j][0] + v[i][j][1] * v[i][j][1]) + (v[i][j][2] * v[i][j][2] + v[i][j][3] * v[i][j][3]); } }
    wave_sum_n<NR>(qa);
#pragma unroll
    for (int i = 0; i < NR; ++i) { qa[i] = 1.f / sqrtf(qa[i] * (1.f / DM) + EPS); if (!FINAL && lane == 0) *(f32x2*)(lnst + row[i] * 2) = (f32x2){sa[i], qa[i]}; }
#pragma unroll
    for (int j = 0; j < 8; ++j) { const f32x4 gg = ((const f32x4*)g)[lane + 64 * j], bb = ((const f32x4*)b)[lane + 64 * j];
#pragma unroll
        for (int i = 0; i < NR; ++i) { const f32x4 o = v[i][j] * qa[i] * gg + bb;
            if (FINAL) __builtin_nontemporal_store(o, (f32x4*)(of + row[i] * DM) + lane + 64 * j);
            else { u32x2 w; w.x = cvt_pk_bf16(o[0], o[1]); w.y = cvt_pk_bf16(o[2], o[3]); ((u32x2*)(ob + row[i] * DM))[lane + 64 * j] = w; } } }
}
template <bool FINAL>
__device__ __forceinline__ void phase_ln(const float* src, const float* g, const float* b, float* of, bf16_t* ob, float* lnst, int vcu, int G, int wv) {
    MK_TID(wv); const int lane = tid & 63, wave = wv; const int NGW = G * NWAVES;
    const int gw = vcu * NWAVES + wave; const bool sp = (M == 16 * NGW);
    for (int q = 0; q * 4 * NGW < M; ++q) { const int m0 = sp ? gw + NGW * (((q & 1) << 3) + (q < 2 ? 1 : 0)) : gw + q * 4 * NGW, st = sp ? 2 * NGW : NGW;
        ln_rows<FINAL, 4>(src, g, b, of, ob, lnst, m0, st, lane); }
}

__device__ __forceinline__ void unpack8(const u32x4 z, float (&f)[8]) { f[0] = bf_lo(z.x); f[1] = bf_hi(z.x); f[2] = bf_lo(z.y); f[3] = bf_hi(z.y); f[4] = bf_lo(z.z); f[5] = bf_hi(z.z); f[6] = bf_lo(z.w); f[7] = bf_hi(z.w); }
__device__ __forceinline__ void phase_pool(const bf16_t* proj, bf16_t* ymix, int vcu, int G, int wv) {
    MK_TID(wv); const int lane = tid & 63, wave = wv;
    const int grp = lane >> 4, w = 2 << grp;
    const float m0 = grp == 0 ? 1.f : 0.f, m1 = grp == 1 ? 1.f : 0.f, m2 = grp == 2 ? 1.f : 0.f, m3 = grp == 3 ? 1.f : 0.f;
    for (int t0 = 4 * (vcu * NWAVES + wave); t0 < M; t0 += 4 * G * NWAVES) {
        const int s0 = t0 & (SEQ - 1);
        const bf16_t* zp = proj + (size_t)t0 * NIN + PJ_Z + 8 * lane;
        u32x4 R[19], gt[4];
#pragma unroll
        for (int r = 0; r < 19; ++r) { R[r] = (u32x4){0u, 0u, 0u, 0u};
            if (r >= 16 || (r >= 16 - w && s0 - 15 + r >= 0)) R[r] = *(const u32x4*)(zp + ((ptrdiff_t)r - 15) * NIN); }
#pragma unroll
        for (int j = 0; j < 4; ++j) gt[j] = *(const u32x4*)(proj + (size_t)(t0 + j) * NIN + PJ_AG + 8 * lane);
        float S[8];
#pragma unroll
        for (int e = 0; e < 8; ++e) S[e] = 0.f;
#pragma unroll
        for (int r = 0; r < 16; ++r) { float f[8]; unpack8(R[r], f);
#pragma unroll
            for (int e = 0; e < 8; ++e) S[e] += f[e]; }
#pragma unroll
        for (int j = 0; j < 4; ++j) {
            if (j > 0) {
                float fa[8], f0[8], f1[8], f2[8], f3[8]; unpack8(R[15 + j], fa); unpack8(R[13 + j], f0); unpack8(R[11 + j], f1); unpack8(R[7 + j], f2); unpack8(R[j - 1], f3);
#pragma unroll
                for (int e = 0; e < 8; ++e) S[e] += fa[e] - (((m0 * f0[e] + m1 * f1[e]) + m2 * f2[e]) + m3 * f3[e]); }
            const int n = (s0 + j + 1) < w ? (s0 + j + 1) : w; const float inv = 1.f / (float)n;
            float c[8], gg[8], o[8]; unpack8(R[15 + j], c); unpack8(gt[j], gg);
#pragma unroll
            for (int e = 0; e < 8; ++e) o[e] = (S[e] * inv - c[e]) * gg[e];
            u32x4 wv_; wv_.x = cvt_pk_bf16(o[0], o[1]); wv_.y = cvt_pk_bf16(o[2], o[3]); wv_.z = cvt_pk_bf16(o[4], o[5]); wv_.w = cvt_pk_bf16(o[6], o[7]);
            *(u32x4*)(ymix + (size_t)(t0 + j) * DM + 8 * lane) = wv_;
        }
    }
}

__device__ __forceinline__ int crow(int r, int hi) { return (r & 3) + 8 * (r >> 2) + 4 * hi; }
constexpr int SG_ROW = 272;
__device__ __forceinline__ void phase_sgu(const Params& p, int l, LAS unsigned char* lds, const bf16_t* proj, const float* sgst, const bf16_t* sgw, bf16_t* ymix, int G, int wv) {
    MK_TID(wv); const int lane = tid & 63, wave = wv, hi = lane >> 5, l32 = lane & 31;
    const float* ng = p.sgu_norm_g + l * 512; const float* nb_ = p.sgu_norm_b + l * 512; const float* bs = p.sgu_b + l * 512;
    for (int it = blockIdx.x; it < 1024; it += G) {
        const int bc = it >> 2, head = it & 3, tok0 = bc * 128;
#pragma unroll
        for (int i = 0; i < 4; ++i) { const int c = tid + 512 * i, s = c >> 4, dc = c & 15; const size_t tok = tok0 + s;
            const f32x4* sp = (const f32x4*)(sgst + tok * 16); const f32x4 q0 = sp[0], q1 = sp[1], q2 = sp[2], q3 = sp[3];
            const float s1 = (q0[0] + q0[2]) + (q1[0] + q1[2]) + (q2[0] + q2[2]) + (q3[0] + q3[2]), s2 = (q0[1] + q0[3]) + (q1[1] + q1[3]) + (q2[1] + q2[3]) + (q3[1] + q3[3]);
            const float mean = s1 * (1.f / 512.f), var = s2 * (1.f / 512.f) - mean * mean, rstd = __builtin_amdgcn_rsqf(fmaxf(var, 0.f) + EPS);
            const u32x4 x = *(const u32x4*)(proj + tok * NIN + PJ_V + head * 128 + dc * 8);
            const float xv[8] = {bf_lo(x.x), bf_hi(x.x), bf_lo(x.y), bf_hi(x.y), bf_lo(x.z), bf_hi(x.z), bf_lo(x.w), bf_hi(x.w)};
            const f32x4 g0 = *(const f32x4*)(ng + head * 128 + dc * 8), g1 = *(const f32x4*)(ng + head * 128 + dc * 8 + 4);
            const f32x4 b0 = *(const f32x4*)(nb_ + head * 128 + dc * 8), b1 = *(const f32x4*)(nb_ + head * 128 + dc * 8 + 4);
#pragma unroll
            for (int j = 0; j < 8; ++j) { const float gj = j < 4 ? g0[j & 3] : g1[j & 3], bj = j < 4 ? b0[j & 3] : b1[j & 3];
                const float v = (xv[j] - mean) * rstd * gj + bj;
                *(LAS bf16_t*)(lds + (dc * 8 + j) * SG_ROW + s * 2) = (bf16_t)(cvt_pk_bf16(v, 0.f) & 0xffffu); } }
        const int tb = wave & 3, dh = wave >> 2;
        const bf16_t* wrow = sgw + ((size_t)((l * 4 + head) * 128) + tb * 32 + l32) * 128 + 8 * hi;
        bf16x8 af[8];
#pragma unroll
        for (int ks = 0; ks < 8; ++ks) { af[ks] = (bf16x8){0, 0, 0, 0, 0, 0, 0, 0}; if (ks < 2 * tb + 2) af[ks] = *(const bf16x8*)(wrow + 16 * ks); }
        __syncthreads();
        f32x16 acc0 = {0, 0, 0, 0, 0, 0, 0, 0, 0, 0, 0, 0, 0, 0, 0, 0}, acc1 = acc0;
        const LAS unsigned char* tb0 = lds + (dh * 64 + l32) * SG_ROW + hi * 16;
#pragma unroll
        for (int ks = 0; ks < 8; ++ks) if (ks < 2 * tb + 2) {
            const bf16x8 b0 = *(const LAS bf16x8*)(tb0 + ks * 32), b1 = *(const LAS bf16x8*)(tb0 + 32 * SG_ROW + ks * 32);
            acc0 = __builtin_amdgcn_mfma_f32_32x32x16_bf16(af[ks], b0, acc0, 0, 0, 0);
            acc1 = __builtin_amdgcn_mfma_f32_32x32x16_bf16(af[ks], b1, acc1, 0, 0, 0);
        }
        LAS float* F = (LAS float*)(lds + 36864);
#pragma unroll
        for (int r = 0; r < 16; ++r) { const int t = tb * 32 + crow(r, hi); F[t * 132 + dh * 64 + l32] = acc0[r]; F[t * 132 + dh * 64 + 32 + l32] = acc1[r]; }
        __syncthreads();
        u32x4 uu[4], cc[4]; float bt[4];
#pragma unroll
        for (int i = 0; i < 4; ++i) { const int c = tid + 512 * i, t = c >> 4, dc = c & 15; const size_t tok = tok0 + t;
            uu[i] = *(const u32x4*)(proj + tok * NIN + PJ_U + head * 128 + dc * 8); cc[i] = *(const u32x4*)(proj + tok * NIN + PJ_CG + head * 128 + dc * 8); bt[i] = bs[head * 128 + t]; }
#pragma unroll
        for (int i = 0; i < 4; ++i) { const int c = tid + 512 * i, t = c >> 4, dc = c & 15; const size_t tok = tok0 + t;
            const f32x4 m0 = *(const LAS f32x4*)(F + t * 132 + dc * 8), m1 = *(const LAS f32x4*)(F + t * 132 + dc * 8 + 4);
            const u32x4 u = uu[i], g = cc[i]; const float b = bt[i];
            u32x4 w; w.x = cvt_pk_bf16(bf_lo(u.x) * (m0[0] + b) * bf_lo(g.x), bf_hi(u.x) * (m0[1] + b) * bf_hi(g.x)); w.y = cvt_pk_bf16(bf_lo(u.y) * (m0[2] + b) * bf_lo(g.y), bf_hi(u.y) * (m0[3] + b) * bf_hi(g.y));
            w.z = cvt_pk_bf16(bf_lo(u.z) * (m1[0] + b) * bf_lo(g.z), bf_hi(u.z) * (m1[1] + b) * bf_hi(g.z)); w.w = cvt_pk_bf16(bf_lo(u.w) * (m1[2] + b) * bf_lo(g.w), bf_hi(u.w) * (m1[3] + b) * bf_hi(g.w));
            *(u32x4*)(ymix + tok * DM + 1536 + head * 128 + dc * 8) = w; }
        __syncthreads();
    }
}

#ifndef ATT_PIPE_QK
#define ATT_PIPE_QK 0
#endif
#ifndef ATT_PIPE_PV
#define ATT_PIPE_PV 0
#endif
namespace att {
__device__ __forceinline__ unsigned cvt_nv(float lo, float hi) { unsigned r; asm("v_cvt_pk_bf16_f32 %0, %1, %2" : "=v"(r) : "v"(lo), "v"(hi)); return r; }
constexpr int KROW = 400, VROW = 136, KBUF = 64 * KROW, VBUF = 128 * VROW, LDS_K = 0, LDS_V = 3 * KBUF;
static_assert(LDS_V + 2 * VBUF <= RING_BYTES, "attention LDS");
__device__ __forceinline__ void unit(LAS unsigned char* lds, int b, int h, int qb, const bf16_t* Q, const bf16_t* Kn, const bf16_t* Kr, const bf16_t* VT, const bf16_t* proj, bf16_t* ymix, int wv) {
    MK_TID(wv); const int lane = tid & 63, wave = wv, hi = lane >> 5, l32 = lane & 31;
#ifdef ATT_FORCE
    const bool shift = ATT_FORCE;
#else
    const bool shift = wave >= 4;
#endif
    const int tok0 = b * SEQ, q0 = qb * 256, NT = 4 * (qb + 1);
    bf16x8 qf[12];
    { const bf16_t* qp = Q + (size_t)(tok0 + q0 + 32 * wave + l32) * NQ + h * 192 + 8 * hi;
#pragma unroll
      for (int ks = 0; ks < 12; ++ks) qf[ks] = *(const bf16x8*)(qp + 16 * ks); }
    const bf16_t* gk = Kn + (size_t)(tok0 + (tid >> 4)) * NKN + h * 128 + (tid & 15) * 8;
    const bf16_t* gr = Kr + (size_t)(tok0 + (tid >> 3)) * 64 + (tid & 7) * 8;
    const bf16_t* gv = VT + (size_t)(h * 128 + (tid >> 3)) * M + tok0 + (tid & 7) * 8;
    const int lk = LDS_K + (tid >> 4) * KROW + (tid & 15) * 16, lr = LDS_K + (tid >> 3) * KROW + 256 + (tid & 7) * 16, lv = LDS_V + (tid >> 3) * VROW + (tid & 7) * 16;
    u32x4 rk0, rk1, rr, rv0, rv1;
#define ATT_LOADK(t) do { rk0 = *(const u32x4*)(gk + (size_t)(64 * (t)) * NKN); rk1 = *(const u32x4*)(gk + (size_t)(64 * (t) + 32) * NKN); rr = *(const u32x4*)(gr + (size_t)(64 * (t)) * 64); } while (0)
#define ATT_LOADV(t) do { rv0 = *(const u32x4*)(gv + 64 * (t)); rv1 = *(const u32x4*)(gv + (size_t)64 * M + 64 * (t)); } while (0)
#define ATT_STOREK(ko) do { *(LAS u32x4*)(lds + (ko) + lk) = rk0; *(LAS u32x4*)(lds + (ko) + lk + 32 * KROW) = rk1; *(LAS u32x4*)(lds + (ko) + lr) = rr; } while (0)
#define ATT_STOREV(vo) do { *(LAS u32x2*)(lds + (vo) + lv) = (u32x2){rv0.x, rv0.y}; *(LAS u32x2*)(lds + (vo) + lv + 8) = (u32x2){rv0.z, rv0.w}; \
        *(LAS u32x2*)(lds + (vo) + lv + 64 * VROW) = (u32x2){rv1.x, rv1.y}; *(LAS u32x2*)(lds + (vo) + lv + 64 * VROW + 8) = (u32x2){rv1.z, rv1.w}; } while (0)
    f32x16 o[4];
#pragma unroll
    for (int i = 0; i < 4; ++i) o[i] = (f32x16){0, 0, 0, 0, 0, 0, 0, 0, 0, 0, 0, 0, 0, 0, 0, 0};
    float mrun = -INFINITY, lrun = 0.f;
    const int qidx = q0 + 32 * wave + l32;
    f32x16 p0, p1; bf16x8 pf[2][2];
#define SB_ __builtin_amdgcn_sched_barrier(0)
#define ATT_KREAD(dst, ks) do { dst[0] = *(const LAS bf16x8*)(kb + (ks) * 32); dst[1] = *(const LAS bf16x8*)(kb + 32 * KROW + (ks) * 32); } while (0)
#if ATT_PIPE_QK
#define ATT_QK(ko) do { const LAS unsigned char* kb = lds + (ko) + LDS_K + l32 * KROW + hi * 16; bf16x8 fa[2][2][2]; \
        p0 = (f32x16){0, 0, 0, 0, 0, 0, 0, 0, 0, 0, 0, 0, 0, 0, 0, 0}; p1 = p0; \
        ATT_KREAD(fa[0][0], 0); ATT_KREAD(fa[0][1], 1); \
        _Pragma("unroll") for (int bt = 0; bt < 6; ++bt) { \
            if (bt + 1 < 6) { ATT_KREAD(fa[(bt + 1) & 1][0], 2 * bt + 2); ATT_KREAD(fa[(bt + 1) & 1][1], 2 * bt + 3); } \
            SB_; \
            p0 = __builtin_amdgcn_mfma_f32_32x32x16_bf16(fa[bt & 1][0][0], qf[2 * bt], p0, 0, 0, 0); p1 = __builtin_amdgcn_mfma_f32_32x32x16_bf16(fa[bt & 1][0][1], qf[2 * bt], p1, 0, 0, 0); \
            p0 = __builtin_amdgcn_mfma_f32_32x32x16_bf16(fa[bt & 1][1][0], qf[2 * bt + 1], p0, 0, 0, 0); p1 = __builtin_amdgcn_mfma_f32_32x32x16_bf16(fa[bt & 1][1][1], qf[2 * bt + 1], p1, 0, 0, 0); \
            SB_; } } while (0)
#else
#define ATT_QK(ko) do { const LAS unsigned char* kb = lds + (ko) + LDS_K + l32 * KROW + hi * 16; \
        p0 = (f32x16){0, 0, 0, 0, 0, 0, 0, 0, 0, 0, 0, 0, 0, 0, 0, 0}; p1 = p0; \
        _Pragma("unroll") for (int ks = 0; ks < 12; ++ks) { const bf16x8 a0 = *(const LAS bf16x8*)(kb + ks * 32), a1 = *(const LAS bf16x8*)(kb + 32 * KROW + ks * 32); \
            p0 = __builtin_amdgcn_mfma_f32_32x32x16_bf16(a0, qf[ks], p0, 0, 0, 0); p1 = __builtin_amdgcn_mfma_f32_32x32x16_bf16(a1, qf[ks], p1, 0, 0, 0); } } while (0)
#endif
#define ATT_QKN(ko) do { const LAS unsigned char* kb = lds + (ko) + LDS_K + l32 * KROW + hi * 16; \
        _Pragma("unroll") for (int ks = 0; ks < 12; ++ks) { const bf16x8 a0 = *(const LAS bf16x8*)(kb + ks * 32), a1 = *(const LAS bf16x8*)(kb + 32 * KROW + ks * 32); \
            if (ks == 0) { p0 = __builtin_amdgcn_mfma_f32_32x32x16_bf16(a0, qf[0], negm, 0, 0, 0); p1 = __builtin_amdgcn_mfma_f32_32x32x16_bf16(a1, qf[0], negm, 0, 0, 0); } \
            else { p0 = __builtin_amdgcn_mfma_f32_32x32x16_bf16(a0, qf[ks], p0, 0, 0, 0); p1 = __builtin_amdgcn_mfma_f32_32x32x16_bf16(a1, qf[ks], p1, 0, 0, 0); } } } while (0)
#define ATT_SM(t) do { \
        if ((t) >= NT - 4) { const int kv0 = 64 * (t) + 4 * hi; \
            _Pragma("unroll") for (int r = 0; r < 16; ++r) { const int kv = kv0 + (r & 3) + 8 * (r >> 2); if (kv > qidx) p0[r] = -INFINITY; if (kv + 32 > qidx) p1[r] = -INFINITY; } } \
        float mx = fmaxf(p0[0], p1[0]); \
        _Pragma("unroll") for (int r = 1; r < 16; ++r) mx = fmaxf(mx, fmaxf(p0[r], p1[r])); \
        mx = fmaxf(mx, shfl_xor_f(mx, 32)); \
        const float mn = fmaxf(mrun, mx), alpha = __builtin_amdgcn_exp2f(mrun - mn); mrun = mn; \
        float rs = 0.f; \
        _Pragma("unroll") for (int r = 0; r < 16; ++r) { p0[r] = __builtin_amdgcn_exp2f(p0[r] - mn); p1[r] = __builtin_amdgcn_exp2f(p1[r] - mn); rs += p0[r] + p1[r]; } \
        lrun = lrun * alpha + rs; \
        if (__any(alpha < 1.f)) { \
            _Pragma("unroll") for (int i = 0; i < 4; ++i) _Pragma("unroll") for (int r = 0; r < 16; ++r) o[i][r] *= alpha; } \
        _Pragma("unroll") for (int j = 0; j < 2; ++j) { u32x4 w0, w1; \
            w0.x = cvt_pk_bf16(p0[8 * j + 0], p0[8 * j + 1]); w0.y = cvt_pk_bf16(p0[8 * j + 2], p0[8 * j + 3]); w0.z = cvt_pk_bf16(p0[8 * j + 4], p0[8 * j + 5]); w0.w = cvt_pk_bf16(p0[8 * j + 6], p0[8 * j + 7]); \
            w1.x = cvt_pk_bf16(p1[8 * j + 0], p1[8 * j + 1]); w1.y = cvt_pk_bf16(p1[8 * j + 2], p1[8 * j + 3]); w1.z = cvt_pk_bf16(p1[8 * j + 4], p1[8 * j + 5]); w1.w = cvt_pk_bf16(p1[8 * j + 6], p1[8 * j + 7]); \
            pf[0][j] = __builtin_bit_cast(bf16x8, w0); pf[1][j] = __builtin_bit_cast(bf16x8, w1); } } while (0)
#define ATT_VREAD(dst, sidx) do { _Pragma("unroll") for (int blk = 0; blk < 4; ++blk) { const int off = blk * 32 * VROW + (sidx) * 32; \
            dst[blk][0] = *(const LAS s16x4*)(vb + off); dst[blk][1] = *(const LAS s16x4*)(vb + off + 16); } } while (0)
#if ATT_PIPE_PV
#define ATT_VREAD(dst, sidx) do { _Pragma("unroll") for (int blk = 0; blk < 4; ++blk) { const int off = blk * 32 * VROW + (sidx) * 32; \
            dst[blk][0] = *(const LAS s16x4*)(vb + off); dst[blk][1] = *(const LAS s16x4*)(vb + off + 16); } } while (0)
#define ATT_PVMMA(sl, blk) do { const s16x4 lo = fv[(sl) & 1][blk][0], hh = fv[(sl) & 1][blk][1]; \
            const bf16x8 a = (bf16x8){lo[0], lo[1], lo[2], lo[3], hh[0], hh[1], hh[2], hh[3]}; \
            o[blk] = __builtin_amdgcn_mfma_f32_32x32x16_bf16(a, pf[(sl) >> 1][(sl) & 1], o[blk], 0, 0, 0); } while (0)
#define ATT_PV(vo) do { const LAS unsigned char* vb = lds + (vo) + LDS_V + l32 * VROW + hi * 8; s16x4 fv[2][4][2]; \
        ATT_VREAD(fv[0], 0); SB_; \
        _Pragma("unroll") for (int sl = 0; sl < 4; ++sl) { \
            ATT_PVMMA(sl, 0); ATT_PVMMA(sl, 1); SB_; \
            if (sl + 1 < 4) ATT_VREAD(fv[(sl + 1) & 1], sl + 1); \
            SB_; \
            ATT_PVMMA(sl, 2); ATT_PVMMA(sl, 3); SB_; } } while (0)
#else
#define ATT_PV(vo) do { const LAS unsigned char* vb = lds + (vo) + LDS_V + l32 * VROW + hi * 8; \
        _Pragma("unroll") for (int blk = 0; blk < 4; ++blk) _Pragma("unroll") for (int hf = 0; hf < 2; ++hf) _Pragma("unroll") for (int j = 0; j < 2; ++j) { const int off = blk * 32 * VROW + (32 * hf + 16 * j) * 2; \
            const s16x4 lo = *(const LAS s16x4*)(vb + off), hh = *(const LAS s16x4*)(vb + off + 16); \
            const bf16x8 a = (bf16x8){lo[0], lo[1], lo[2], lo[3], hh[0], hh[1], hh[2], hh[3]}; \
            o[blk] = __builtin_amdgcn_mfma_f32_32x32x16_bf16(a, pf[hf][j], o[blk], 0, 0, 0); } } while (0)
#endif
    ATT_LOADK(0); ATT_LOADV(0); ATT_STOREK(0); ATT_STOREV(0);
    ATT_LOADK(1); ATT_STOREK(KBUF);
    __syncthreads();
#pragma unroll
    for (int ks = 0; ks < 12; ++ks) asm volatile("" : "+v"(qf[ks]));
    int k0 = 0, k1 = KBUF, k2 = 2 * KBUF, v0 = 0, v1 = VBUF;
#define ATT_TOP(t) do { if ((t) + 2 < NT) ATT_LOADK((t) + 2); if ((t) + 1 < NT) ATT_LOADV((t) + 1); } while (0)
#define ATT_BOT(t) do { if ((t) + 2 < NT) ATT_STOREK(k2); if ((t) + 1 < NT) ATT_STOREV(v1); __syncthreads(); \
        { const int kk = k0; k0 = k1; k1 = k2; k2 = kk; const int vv = v0; v0 = v1; v1 = vv; } } while (0)
    bf16x8 pf2[2][2]; float alpha_n = 1.f;
#define ATT_SMA(t, MASKED) do { \
        if (MASKED) { const int kv0 = 64 * (t) + 4 * hi; \
            _Pragma("unroll") for (int r = 0; r < 16; ++r) { const int kv = kv0 + (r & 3) + 8 * (r >> 2); if (kv > qidx) p0[r] = -INFINITY; if (kv + 32 > qidx) p1[r] = -INFINITY; } } \
        float mx = fmaxf(p0[0], p1[0]); \
        _Pragma("unroll") for (int r = 1; r < 16; ++r) mx = fmaxf(mx, fmaxf(p0[r], p1[r])); \
        mx = fmaxf(mx, shfl_xor_f(mx, 32)); \
        const float mn = fmaxf(mrun, mx); alpha_n = __builtin_amdgcn_exp2f(mrun - mn); mrun = mn; \
        float rs = 0.f; \
        _Pragma("unroll") for (int r = 0; r < 16; ++r) { p0[r] = __builtin_amdgcn_exp2f(p0[r] - mn); p1[r] = __builtin_amdgcn_exp2f(p1[r] - mn); rs += p0[r] + p1[r]; } \
        lrun = lrun * alpha_n + rs; \
        _Pragma("unroll") for (int j = 0; j < 2; ++j) { u32x4 w0, w1; \
            w0.x = cvt_nv(p0[8 * j + 0], p0[8 * j + 1]); w0.y = cvt_nv(p0[8 * j + 2], p0[8 * j + 3]); w0.z = cvt_nv(p0[8 * j + 4], p0[8 * j + 5]); w0.w = cvt_nv(p0[8 * j + 6], p0[8 * j + 7]); \
            w1.x = cvt_nv(p1[8 * j + 0], p1[8 * j + 1]); w1.y = cvt_nv(p1[8 * j + 2], p1[8 * j + 3]); w1.z = cvt_nv(p1[8 * j + 4], p1[8 * j + 5]); w1.w = cvt_nv(p1[8 * j + 6], p1[8 * j + 7]); \
            pf2[0][j] = __builtin_bit_cast(bf16x8, w0); pf2[1][j] = __builtin_bit_cast(bf16x8, w1); } } while (0)
#define ATT_RESC() do { if (__any(alpha_n < 1.f)) { _Pragma("unroll") for (int i = 0; i < 4; ++i) _Pragma("unroll") for (int r = 0; r < 16; ++r) o[i][r] *= alpha_n; } } while (0)
    ATT_QK(0);
    if (NT <= 4) ATT_SMA(0, true); else ATT_SMA(0, false);
    pf[0][0] = pf2[0][0]; pf[0][1] = pf2[0][1]; pf[1][0] = pf2[1][0]; pf[1][1] = pf2[1][1];
    float mref = mrun; f32x16 negm;
#pragma unroll
    for (int r = 0; r < 16; ++r) negm[r] = -mref;
    int t = 0;
#define ATT_VRD(i) do { const int sl_ = (i) >> 2, blk_ = (i) & 3, off_ = blk_ * 32 * VROW + sl_ * 32; fv[(i) & 3][0] = *(const LAS s16x4*)(vb + off_); fv[(i) & 3][1] = *(const LAS s16x4*)(vb + off_ + 16); } while (0)
#define ATT_FUSED(tt, MASKED) do { const LAS unsigned char* vb = lds + v0 + LDS_V + l32 * VROW + hi * 8; s16x4 fv[4][2]; \
        float mxa = -INFINITY, mxb = -INFINITY; f32x2 rs2 = (f32x2){0.f, 0.f}; u32x4 w0a, w1a, w0b, w1b; \
        ATT_VRD(0); \
        _Pragma("unroll") for (int i = 0; i < 16; ++i) { \
            if (i + 1 < 16) ATT_VRD(i + 1); \
            { const int sl_ = i >> 2, blk_ = i & 3; const s16x4 lo = fv[i & 3][0], hh = fv[i & 3][1]; \
              const bf16x8 a_ = (bf16x8){lo[0], lo[1], lo[2], lo[3], hh[0], hh[1], hh[2], hh[3]}; \
              o[blk_] = __builtin_amdgcn_mfma_f32_32x32x16_bf16(a_, pf[sl_ >> 1][sl_ & 1], o[blk_], 0, 0, 0); } \
            if (i < 4) { \
                _Pragma("unroll") for (int r = 4 * i; r < 4 * i + 4; ++r) { \
                    if (MASKED) { const int kv = 64 * (tt) + 4 * hi + (r & 3) + 8 * (r >> 2); if (kv > qidx) p0[r] = -INFINITY; if (kv + 32 > qidx) p1[r] = -INFINITY; } \
                    mxa = fmaxf(mxa, p0[r]); mxb = fmaxf(mxb, p1[r]); } \
            } else if (i == 4) { \
                float mx = fmaxf(mxa, mxb); mx = fmaxf(mx, shfl_xor_f(mx, 32)); alpha_n = 1.f; \
                if (__any(mx > 8.f)) { const float dl = fmaxf(mx, 0.f); mref += dl; alpha_n = __builtin_amdgcn_exp2f(-dl); \
                    _Pragma("unroll") for (int r = 0; r < 16; ++r) { p0[r] -= dl; p1[r] -= dl; negm[r] = -mref; } } \
            } else if (i < 13) { \
                _Pragma("unroll") for (int r = 2 * (i - 5); r < 2 * (i - 5) + 2; ++r) { p0[r] = __builtin_amdgcn_exp2f(p0[r]); p1[r] = __builtin_amdgcn_exp2f(p1[r]); rs2 += (f32x2){p0[r], p1[r]}; } \
            } else if (i == 13) { lrun = lrun * alpha_n + (rs2.x + rs2.y); \
                w0a.x = cvt_nv(p0[0], p0[1]); w0a.y = cvt_nv(p0[2], p0[3]); w0a.z = cvt_nv(p0[4], p0[5]); w0a.w = cvt_nv(p0[6], p0[7]); pf[0][0] = __builtin_bit_cast(bf16x8, w0a); \
                w0b.x = cvt_nv(p0[8], p0[9]); w0b.y = cvt_nv(p0[10], p0[11]); w0b.z = cvt_nv(p0[12], p0[13]); w0b.w = cvt_nv(p0[14], p0[15]); pf[0][1] = __builtin_bit_cast(bf16x8, w0b); \
            } else if (i == 14) { \
                w1a.x = cvt_nv(p1[0], p1[1]); w1a.y = cvt_nv(p1[2], p1[3]); w1a.z = cvt_nv(p1[4], p1[5]); w1a.w = cvt_nv(p1[6], p1[7]); pf[1][0] = __builtin_bit_cast(bf16x8, w1a); \
            } else { \
                w1b.x = cvt_nv(p1[8], p1[9]); w1b.y = cvt_nv(p1[10], p1[11]); w1b.z = cvt_nv(p1[12], p1[13]); w1b.w = cvt_nv(p1[14], p1[15]); } \
            __builtin_amdgcn_sched_barrier(0); } \
        pf[1][1] = __builtin_bit_cast(bf16x8, w1b); } while (0)
    for (; t + 1 < NT - 4; ++t) { ATT_TOP(t); ATT_QKN(k1); __builtin_amdgcn_sched_barrier(0); ATT_FUSED(t + 1, false); ATT_RESC(); ATT_BOT(t); }
    for (; t + 1 < NT; ++t) { ATT_TOP(t); ATT_QKN(k1); __builtin_amdgcn_sched_barrier(0); ATT_FUSED(t + 1, true); ATT_RESC(); ATT_BOT(t); }
#undef ATT_FUSED
#undef ATT_VRD
    { ATT_PV(v0); ATT_BOT(t); }
#undef ATT_TOP
#undef ATT_BOT
#undef ATT_SMA
#undef ATT_RESC
#undef ATT_LOADK
#undef ATT_LOADV
#undef ATT_STOREK
#undef ATT_STOREV
#undef ATT_QK
#undef ATT_QKN
#undef ATT_KREAD
#undef ATT_VREAD
#undef SB_
#undef ATT_SM
#undef ATT_PV
    lrun += shfl_xor_f(lrun, 32);
    const float inv = 1.f / lrun;
    const size_t tok = (size_t)tok0 + qidx;
    u32x2 gts[4][4];
#pragma unroll
    for (int blk = 0; blk < 4; ++blk)
#pragma unroll
        for (int g = 0; g < 4; ++g) gts[blk][g] = *(const u32x2*)(proj + tok * NIN + PJ_BG + h * 128 + 32 * blk + 8 * g + 4 * hi);
#pragma unroll
    for (int blk = 0; blk < 4; ++blk)
#pragma unroll
        for (int g = 0; g < 4; ++g) { const int dv = 32 * blk + 8 * g + 4 * hi; const u32x2 gt = gts[blk][g];
            u32x2 w; w.x = cvt_pk_bf16(o[blk][4 * g + 0] * inv * bf_lo(gt.x), o[blk][4 * g + 1] * inv * bf_hi(gt.x)); w.y = cvt_pk_bf16(o[blk][4 * g + 2] * inv * bf_lo(gt.y), o[blk][4 * g + 3] * inv * bf_hi(gt.y));
            *(u32x2*)(ymix + tok * DM + 512 + h * 128 + dv) = w; }
}
__device__ __forceinline__ void phase(LAS unsigned char* lds, const bf16_t* Q, const bf16_t* Kn, const bf16_t* Kr, const bf16_t* VT, const bf16_t* proj, bf16_t* ymix, int vcu, int G, int wv) {
    for (int n = vcu; n < 1024; n += G) {
        const int i = n >> 8, c = n & 255, bh = c >> 1, par = c & 1;
        const int qb = par ? (5 - i) : (i < 2 ? 7 - i : 3 - i);
        unit(lds, bh >> 3, bh & 7, qb, Q, Kn, Kr, VT, proj, ymix, wv);
    }
}
}

#define XB_TMO      128
#define XB_XCNT(j)  (256  + 64 * (j))
#define XB_XSUB(j)  (1280 + 64 * (j))
#define XB_XGEN(j)  (2304 + 64 * (j))
#define XB_TOP      3328
#define XB_TOPGEN   3392
#define XCD_BAR_WORDS 3456
#define XB_SPIN_CAP (1u << 18)
constexpr int XB_LDS_OFF = 131072 + 64;
__device__ __forceinline__ unsigned xb_ld(unsigned* p)              { return __hip_atomic_load(p, __ATOMIC_RELAXED, __HIP_MEMORY_SCOPE_AGENT); }
__device__ __forceinline__ unsigned xb_add(unsigned* p, unsigned v) { return __hip_atomic_fetch_add(p, v, __ATOMIC_RELAXED, __HIP_MEMORY_SCOPE_AGENT); }
__device__ __forceinline__ unsigned xb_xcc_id() { return (unsigned)__builtin_amdgcn_s_getreg((3 << 11) | 20) & 0xFu; }
#define XB_SPIN(cond, bar) do { unsigned _sp = 0; while (cond) { __builtin_amdgcn_s_sleep(1); \
    if ((++_sp & 255u) == 0u) { if (xb_ld(&(bar)[XB_TMO])) break; if (_sp > XB_SPIN_CAP) { atomicAdd(&(bar)[XB_TMO], 1u); break; } } } } while (0)
__device__ __forceinline__ void xcd_barrier_complete(unsigned* bar, unsigned x, unsigned& nloc, unsigned& nx) {
    const unsigned G = gridDim.x * gridDim.y * gridDim.z;
    unsigned sum, cnt, mine, sp = 0u;
    for (;;) {
        sum = 0u; cnt = 0u; mine = 0u;
#pragma unroll
        for (unsigned j = 0; j < 16; ++j) { const unsigned c = xb_ld(&bar[XB_XCNT(j)]); sum += c; cnt += (c > 0u) ? 1u : 0u; mine = (j == x) ? c : mine; }
        if (sum == G) break;
        __builtin_amdgcn_s_sleep(1);
        if ((++sp & 255u) == 0u) { if (xb_ld(&bar[XB_TMO])) break; if (sp > XB_SPIN_CAP) { atomicAdd(&bar[XB_TMO], 1u); break; } }
    }
    nloc = mine > 0u ? mine : 1u; nx = cnt > 0u ? cnt : 1u;
}
__device__ __forceinline__ void xcd_barrier(unsigned* bar, LAS unsigned char* lds, int wv) {
    asm volatile("s_waitcnt vmcnt(0)" ::: "memory");
    __syncthreads();
    int lane = lane_id(); asm volatile("" : "+v"(lane));
    if (wv == 0 && lane == 0) {
        volatile LAS unsigned* st = (volatile LAS unsigned*)(lds + XB_LDS_OFF);
        const unsigned x = xb_xcc_id();
        __builtin_amdgcn_s_waitcnt(0);
        unsigned nloc = st[0], nx = st[1];
        if (nloc == 0u) { (void)xb_add(&bar[XB_XCNT(x)], 1u); xcd_barrier_complete(bar, x, nloc, nx); st[0] = nloc; st[1] = nx; }
        const unsigned old = xb_add(&bar[XB_XSUB(x)], 1u);
        const unsigned gen = old / nloc;
        if (old + 1u == (gen + 1u) * nloc) {
            __builtin_amdgcn_fence(__ATOMIC_RELEASE, "agent");
            asm volatile("s_waitcnt vmcnt(0)" ::: "memory");
            const unsigned og = xb_add(&bar[XB_TOP], 1u);
            const unsigned tg = og / nx;
            if (og + 1u == (tg + 1u) * nx) xb_add(&bar[XB_TOPGEN], 1u);
            else XB_SPIN(xb_ld(&bar[XB_TOPGEN]) == tg, bar);
            __builtin_amdgcn_fence(__ATOMIC_ACQUIRE, "agent");
            xb_add(&bar[XB_XGEN(x)], 1u);
            asm volatile("s_waitcnt vmcnt(0)" ::: "memory");
        } else {
            XB_SPIN(xb_ld(&bar[XB_XGEN(x)]) == gen, bar);
            __builtin_amdgcn_fence(__ATOMIC_ACQUIRE, "agent");
            asm volatile("s_waitcnt vmcnt(0)" ::: "memory");
        }
    }
    __syncthreads();
}
#ifndef USE_XB
#define USE_XB 1
#endif
#if MK_MULTI
#define IN(k) (p.ph_lo <= (k) && (k) < p.ph_hi)
#else
#define IN(k) true
#endif
#ifndef SYNC_REP
#define SYNC_REP 1
#endif
#define SEAM(k) do { if (IN(k) && IN((k) + 1)) { for (int sr_ = 0; sr_ < SYNC_REP; ++sr_) { if (!USE_XB || (k) == 0) cg::this_grid().sync(); else xcd_barrier((unsigned*)p.ws, lds, wv); } } } while (0)
template <int l>
__device__ __forceinline__ void layer_body(const Params& p, LAS unsigned char* lds, int G, int bx, int vcu, int wv) {
    unsigned char* ws;
        const int P = 1 + 5 * l;
        { size_t zo_ = 0; asm volatile("" : "+s"(zo_)); ws = p.ws + zo_; }
    float* hf = (float*)(ws + WS_HF); bf16_t* hb = (bf16_t*)(ws + WS_HB); bf16_t* ymix = hb;
    bf16_t* proj = (bf16_t*)(ws + WS_PROJ); bf16_t* Qb = (bf16_t*)(ws + WS_Q); bf16_t* Knb = (bf16_t*)(ws + WS_KN); bf16_t* VTb = (bf16_t*)(ws + WS_VT);
    bf16_t* krope = (bf16_t*)(ws + WS_KR); float* ssq = (float*)(ws + WS_SSQ); float* sgst = (float*)(ws + WS_SGST);
    const float* cosT = (const float*)(ws + WS_COS); const float* sinT = (const float*)(ws + WS_SIN);
        if (IN(P)) REP(1) {
            pg8::Gemm g{hb, (const bf16_t*)(ws + WS_WIN) + (size_t)l * NIN * DM};
            pg8::StaticOrder S; S.init(M, NIN, G, bx);
            pg8::EpiIn E{proj, krope, ssq, sgst, cosT, sinT};
            if PHM(2) pg8::gemm_phase<DM, DM, DM>(lds, g, S, E, wv);
        }
        SEAM(P);
        if (IN(P + 1)) {
            REP(9) if PHM(6) phase_sgu(p, l, lds, proj, sgst, (const bf16_t*)(ws + WS_SGW), ymix, G, wv);
            REP(10) if PHM(7) phase_pool(proj, ymix, vcu, G, wv);
            __syncthreads();
            REP(7) { pg8::Gemm g{proj + PJ_CKV, (const bf16_t*)(ws + WS_WKV) + (size_t)l * 2048 * 256};
              pg8::StaticOrder S; S.init(M, NKN, G, bx); pg8::EpiKn E{Knb, ssq}; if PHM(4) pg8::gemm_phase<256, NIN, 256>(lds, g, S, E, wv); }
            REP(8) { pg8::Gemm g{(const bf16_t*)(ws + WS_WKV) + (size_t)l * 2048 * 256 + (size_t)1024 * 256, proj + PJ_CKV};
              pg8::StaticOrder S; S.init(NVT, M, G, bx); pg8::EpiVT E{VTb, ssq}; if PHM(5) pg8::gemm_phase<256, 256, NIN>(lds, g, S, E, wv); }
            REP(6) { pg8::Gemm g{proj + PJ_CQ, (const bf16_t*)(ws + WS_WQ) + (size_t)l * NQ * 512};
              pg8::StaticOrder S; S.init(M, NQ, G, bx); pg8::EpiQ E{Qb, ssq, cosT, sinT}; if PHM(3) pg8::gemm_phase<512, NIN, 512>(lds, g, S, E, wv); }
        }
        SEAM(P + 1);
        if (IN(P + 2)) REP(3) if PHM(8) att::phase(lds, Qb, Knb, krope, VTb, proj, ymix, vcu, G, wv);
        SEAM(P + 2);
        if (IN(P + 3)) REP(4) {
            pg8::Gemm g{ymix, (const bf16_t*)(ws + WS_WO) + (size_t)l * DM * DM};
            pg8::StaticOrder S; S.init(M, DM, G, bx);
            pg8::EpiOut E{l == 0 ? p.x : (const float*)p.out, hf, l == 0 ? p.ln_in_g : p.ln_post_g + (l - 1) * DM, l == 0 ? p.ln_in_b : p.ln_post_b + (l - 1) * DM, p.out, p.b_out + l * DM};
            if PHM(9) pg8::gemm_phase<DM, DM, DM>(lds, g, S, E, wv);
        }
        SEAM(P + 3);
        if (IN(P + 4)) for (int rep_ = 0; rep_ < 1 + (((DBL_MASK >> 5) & 1) && l == 0); ++rep_) {
            if (l == DEPTH - 1) phase_ln<true>(p.out, p.ln_post_g + l * DM, p.ln_post_b + l * DM, p.out, nullptr, nullptr, vcu, G, wv);
            else phase_ln<false>(p.out, p.ln_post_g + l * DM, p.ln_post_b + l * DM, nullptr, hb, hf, vcu, G, wv);
        }
        if (l < DEPTH - 1) SEAM(P + 4);
    }
__global__ void __launch_bounds__(NTHREADS, 2) fwd_kernel(Params p) {
    extern __shared__ __attribute__((aligned(16))) unsigned char lds_raw[];
    LAS unsigned char* lds = (LAS unsigned char*)lds_raw;
    const int G = gridDim.x, bx = blockIdx.x;
    const int wv = __builtin_amdgcn_readfirstlane((int)threadIdx.x >> 6);
    const int vcu = (G % 8 == 0) ? (bx % 8) * (G / 8) + bx / 8 : bx;
    unsigned char* ws = p.ws;
    if (USE_XB) {
        { MK_TID(wv);
          if (tid < 2) ((LAS unsigned*)(lds + XB_LDS_OFF))[tid] = 0u;
          if (bx == 0) for (int i = tid; i < XCD_BAR_WORDS; i += NTHREADS) ((unsigned*)p.ws)[i] = 0u; }
        __syncthreads();
    }
    if (IN(0)) {
        REP(0) if PHM(0) phase_prologue(p, lds, vcu, G, wv);
        REP(11) if PHM(1) phase_ln<false>(p.x, p.ln_in_g, p.ln_in_b, nullptr, (bf16_t*)(ws + WS_HB), (float*)(ws + WS_HF), vcu, G, wv);
    }
    SEAM(0);
    layer_body<0>(p, lds, G, bx, vcu, wv);
    layer_body<1>(p, lds, G, bx, vcu, wv);
#undef IN
#undef SEAM
}
constexpr int NPHASES = 1 + 5 * DEPTH;

extern "C" void kernel_launch(void* const* d_in, const int* in_sizes, int n_in, void* d_out, int out_size, void* d_ws, size_t ws_size, hipStream_t stream) {
    static int grid = 0;
    if (grid == 0) {
        if (n_in != 19 || out_size != M * DM || ws_size < WS_END) { fprintf(stderr, "kernel_launch: unexpected problem (n_in %d, out %d, ws %zu); nothing launched\n", n_in, out_size, ws_size); grid = -1; return; }
        int dev = 0, cus = 0, per_cu = 0;
        (void)hipGetDevice(&dev); (void)hipDeviceGetAttribute(&cus, hipDeviceAttributeMultiprocessorCount, dev);
        if (hipFuncSetAttribute((const void*)fwd_kernel, hipFuncAttributeMaxDynamicSharedMemorySize, LDS_BYTES) != hipSuccess) { fprintf(stderr, "kernel_launch: hipFuncSetAttribute failed\n"); grid = -1; return; }
        if (hipOccupancyMaxActiveBlocksPerMultiprocessor(&per_cu, (const void*)fwd_kernel, NTHREADS, LDS_BYTES) != hipSuccess || per_cu < 1) { fprintf(stderr, "kernel_launch: occupancy query says %d\n", per_cu); per_cu = 1; }
        (void)hipGetLastError();
        grid = cus * (per_cu > 1 ? 1 : per_cu);
        if (grid <= 0) grid = 256;
    }
    if (grid < 0) return;
    Params p{};
    p.x = (const float*)d_in[0]; p.pos = (const int*)d_in[1]; p.ln_in_g = (const float*)d_in[2]; p.ln_in_b = (const float*)d_in[3]; p.w_in = (const float*)d_in[4];
    p.pool_w = (const float*)d_in[5]; p.pool_scale = (const float*)d_in[6]; p.q_norm_g = (const float*)d_in[7]; p.w_uq = (const float*)d_in[8]; p.kv_norm_g = (const float*)d_in[9];
    p.w_ukv = (const float*)d_in[10]; p.sgu_norm_g = (const float*)d_in[11]; p.sgu_norm_b = (const float*)d_in[12]; p.sgu_w = (const float*)d_in[13]; p.sgu_b = (const float*)d_in[14];
    p.w_out = (const float*)d_in[15]; p.b_out = (const float*)d_in[16]; p.ln_post_g = (const float*)d_in[17]; p.ln_post_b = (const float*)d_in[18];
    p.out = (float*)d_out; p.ws = (unsigned char*)d_ws;
    for (int i = 0; i < 32; ++i) p.inv_freq[i] = (float)pow(10000.0, -(double)i / 32.0);
#if MK_MULTI
    for (int k = 0; k < NPHASES; ++k) { p.ph_lo = k; p.ph_hi = k + 1; hipLaunchKernelGGL(fwd_kernel, dim3(grid), dim3(NTHREADS), LDS_BYTES, stream, p); }
#else
    p.ph_lo = 0; p.ph_hi = NPHASES;
    void* args[] = {&p};
    hipError_t e = hipLaunchCooperativeKernel((const void*)fwd_kernel, dim3(grid), dim3(NTHREADS), args, LDS_BYTES, stream);
    if (e != hipSuccess) fprintf(stderr, "kernel_launch: cooperative launch failed: %s (grid %d)\n", hipGetErrorString(e), grid);
#endif
}
```
